# Optimizing an MI355X kernel written in HIP

```python
import jax, jax.numpy as jnp
from jax import lax
import numpy as np

D_MODEL = 2048
BATCH = 8
SEQ = 2048
DEPTH = 2

MEM_TOKENS = 256
MEM_HEADS = 4
MEM_HEAD_DIM = 256
MEM_WIDTH = MEM_HEADS * MEM_HEAD_DIM
MLA_HEADS = 8
Q_LORA_RANK = 512
KV_LORA_RANK = 256
QK_NOPE_DIM = 128
QK_ROPE_DIM = 64
QK_HEAD_DIM = QK_NOPE_DIM + QK_ROPE_DIM
V_HEAD_DIM = 128
MLA_WIDTH = MLA_HEADS * V_HEAD_DIM
ROPE_THETA = 10000.0
Q_BLOCK = 128
POOL_WINDOWS = (2, 4, 8, 16)
POOL_GROUPS = 4
POOL_GROUP_DIM = 256
POOL_WIDTH = POOL_GROUPS * POOL_GROUP_DIM
N_BRANCHES = 3
IN_SPLITS = (Q_LORA_RANK,
             Q_LORA_RANK + KV_LORA_RANK + QK_ROPE_DIM,
             Q_LORA_RANK + KV_LORA_RANK + QK_ROPE_DIM + POOL_WIDTH,
             Q_LORA_RANK + KV_LORA_RANK + QK_ROPE_DIM + POOL_WIDTH + MEM_WIDTH)
IN_WIDTH = IN_SPLITS[-1] + N_BRANCHES * D_MODEL
D_FF_DENSE = 5632
N_EXPERTS = 8
TOP_K = 2
D_FF_EXPERT = 7168
MOE_BLOCK = 256
N_DENSE_LAYERS = (DEPTH + 1) // 2
N_MOE_LAYERS = DEPTH // 2
NORM_EPS = 1e-6

kernel_name = 'hybrid_mla_pool_memory_moe_block'


def rmsnorm(x, g):
    xf = x.astype(jnp.float32)
    y = xf * lax.rsqrt(jnp.mean(xf * xf, axis=-1, keepdims=True) + NORM_EPS)
    return (y * g.astype(jnp.float32)).astype(x.dtype)


def rope_tables(positions):
    inv_freq = ROPE_THETA ** (-jnp.arange(0, QK_ROPE_DIM, 2, dtype=jnp.float32) / QK_ROPE_DIM)
    ang = positions.astype(jnp.float32)[..., None] * inv_freq
    return jnp.cos(ang)[:, :, None, :], jnp.sin(ang)[:, :, None, :]


def apply_rope(x, cos, sin):
    half = x.shape[-1] // 2
    x1, x2 = x[..., :half], x[..., half:]
    c = cos.astype(x.dtype)
    s = sin.astype(x.dtype)
    return jnp.concatenate([x1 * c - x2 * s, x2 * c + x1 * s], axis=-1)


def rope_tail(x, cos, sin):
    return jnp.concatenate([x[..., :QK_NOPE_DIM], apply_rope(x[..., QK_NOPE_DIM:], cos, sin)], axis=-1)


def causal_block_attention(q, k, v):
    B, S, H, Dh = q.shape
    nq = S // Q_BLOCK
    scale = Dh ** -0.5
    qb = q.reshape(B, nq, Q_BLOCK, H, Dh).transpose(1, 0, 2, 3, 4)
    kpos = jnp.arange(S)

    def one_block(args):
        qi, i = args
        s = jnp.einsum('bqhd,bkhd->bhqk', qi, k, preferred_element_type=jnp.float32) * scale
        qpos = i * Q_BLOCK + jnp.arange(Q_BLOCK)
        s = jnp.where(qpos[:, None] >= kpos[None, :], s, -jnp.inf)
        p = jax.nn.softmax(s, axis=-1).astype(v.dtype)
        return jnp.einsum('bhqk,bkhd->bqhd', p, v)

    o = lax.map(one_block, (qb, jnp.arange(nq)))
    return o.transpose(1, 0, 2, 3, 4).reshape(B, S, H, v.shape[-1])


def causal_multiscale_pool(u):
    B, S, G, C = u.shape
    uf = u.astype(jnp.float32)
    cs = jnp.concatenate([jnp.zeros((B, 1, G, C), jnp.float32), jnp.cumsum(uf, axis=1)], axis=1)
    t1 = jnp.arange(1, S + 1, dtype=jnp.float32)
    outs = []
    for g, w in enumerate(POOL_WINDOWS):
        c = cs[:, :, g]
        lo = jnp.concatenate([jnp.zeros((B, w - 1, C), jnp.float32), c[:, :S + 1 - w]], axis=1)
        mean = (c[:, 1:] - lo) / jnp.minimum(t1, float(w))[None, :, None]
        outs.append(mean - uf[:, :, g])
    return jnp.stack(outs, axis=2).astype(u.dtype)


def memory_cross_attention(q, k, v):
    s = jnp.einsum('bshd,bmhd->bhsm', q, k, preferred_element_type=jnp.float32) * (q.shape[-1] ** -0.5)
    p = jax.nn.softmax(s, axis=-1).astype(v.dtype)
    return jnp.einsum('bhsm,bmhd->bshd', p, v)


def token_mixer(h, mem_n, cos, sin, w_in, mla_q_a_norm_g, mla_w_uq, mla_kv_a_norm_g, mla_w_ukv,
                mla_q_norm_g, mla_k_norm_g, mla_w_out, pool_w, pool_scale, pool_w_out,
                mem_w_kv, mem_q_norm_g, mem_k_norm_g, mem_w_out, w_o):
    B, S, _ = h.shape
    M = mem_n.shape[1]
    z = h @ w_in
    cq, ckv, u_pool, q_mem, gate_logits = jnp.split(z, IN_SPLITS, axis=-1)

    q = (rmsnorm(cq, mla_q_a_norm_g) @ mla_w_uq).reshape(B, S, MLA_HEADS, QK_HEAD_DIM)
    c_kv, k_pe = ckv[..., :KV_LORA_RANK], ckv[..., KV_LORA_RANK:]
    kv = (rmsnorm(c_kv, mla_kv_a_norm_g) @ mla_w_ukv).reshape(B, S, MLA_HEADS, QK_NOPE_DIM + V_HEAD_DIM)
    k_nope, v = kv[..., :QK_NOPE_DIM], kv[..., QK_NOPE_DIM:]
    k = jnp.concatenate([k_nope, jnp.broadcast_to(k_pe[:, :, None, :], (B, S, MLA_HEADS, QK_ROPE_DIM))], axis=-1)
    q = rope_tail(rmsnorm(q, mla_q_norm_g), cos, sin)
    k = rope_tail(rmsnorm(k, mla_k_norm_g), cos, sin)
    o_mla = causal_block_attention(q, k, v).reshape(B, S, MLA_WIDTH) @ mla_w_out

    pooled = causal_multiscale_pool(u_pool.reshape(B, S, POOL_GROUPS, POOL_GROUP_DIM))
    mixed = jnp.einsum('bsgc,gcd->bsgd', pooled, pool_w).reshape(B, S, POOL_WIDTH) * pool_scale
    o_pool = mixed @ pool_w_out

    kv_m = mem_n @ mem_w_kv
    k_m = rmsnorm(kv_m[..., :MEM_WIDTH].reshape(B, M, MEM_HEADS, MEM_HEAD_DIM), mem_k_norm_g)
    v_m = kv_m[..., MEM_WIDTH:].reshape(B, M, MEM_HEADS, MEM_HEAD_DIM)
    q_m = rmsnorm(q_mem.reshape(B, S, MEM_HEADS, MEM_HEAD_DIM), mem_q_norm_g)
    o_mem = memory_cross_attention(q_m, k_m, v_m).reshape(B, S, MEM_WIDTH) @ mem_w_out

    gates = jax.nn.sigmoid(gate_logits.reshape(B, S, N_BRANCHES, D_MODEL))
    merged = gates[:, :, 0] * o_mla + gates[:, :, 1] * o_pool + gates[:, :, 2] * o_mem
    return merged @ w_o


def dense_swiglu(h, w_gate, w_up, w_down):
    return (jax.nn.silu(h @ w_gate) * (h @ w_up)) @ w_down


def moe_swiglu(h, router_w, router_b, w_gate, w_up, w_down):
    B, S, D = h.shape
    T = B * S
    A = T * TOP_K
    xt = h.reshape(T, D)
    logits = xt.astype(jnp.float32) @ router_w.astype(jnp.float32) + router_b.astype(jnp.float32)
    top_logit, top_idx = lax.top_k(logits, TOP_K)
    top_gate = jax.nn.softmax(top_logit, axis=-1)
    flat_e = top_idx.reshape(A)
    flat_tok = jnp.repeat(jnp.arange(T, dtype=jnp.int32), TOP_K)
    flat_w = top_gate.reshape(A)
    order = jnp.argsort(flat_e, stable=True)
    se, stok, sw = flat_e[order], flat_tok[order], flat_w[order]
    counts = jnp.bincount(flat_e, length=N_EXPERTS)
    starts = jnp.cumsum(counts) - counts
    padded = (counts + MOE_BLOCK - 1) // MOE_BLOCK * MOE_BLOCK
    pends = jnp.cumsum(padded)
    pstarts = pends - padded
    dest = pstarts[se] + (jnp.arange(A) - starts[se])
    n_blocks = -(-A // MOE_BLOCK) + N_EXPERTS
    n_slots = n_blocks * MOE_BLOCK
    slot_tok = jnp.full((n_slots,), T, jnp.int32).at[dest].set(stok)
    slot_w = jnp.zeros((n_slots,), jnp.float32).at[dest].set(sw)
    block_e = jnp.clip(jnp.searchsorted(pends, jnp.arange(n_blocks) * MOE_BLOCK, side='right'), 0, N_EXPERTS - 1)
    x_pad = jnp.concatenate([xt, jnp.zeros((1, D), xt.dtype)], axis=0)
    xs = x_pad[slot_tok].reshape(n_blocks, MOE_BLOCK, D)

    def expert_block(args):
        xb, e = args
        return (jax.nn.silu(xb @ w_gate[e]) * (xb @ w_up[e])) @ w_down[e]

    ys = lax.map(expert_block, (xs, block_e)).reshape(n_slots, D)
    y = jax.ops.segment_sum(ys * slot_w[:, None].astype(ys.dtype), slot_tok, num_segments=T + 1)[:T]
    return y.reshape(B, S, D)


def setup_inputs(seed: int = 0) -> dict:
    key = jax.random.key(seed)
    ks = iter(jax.random.split(key, 32))
    L, ND, NM = DEPTH, N_DENSE_LAYERS, N_MOE_LAYERS

    def w(shape, fan_in):
        return jax.random.normal(next(ks), shape, jnp.float32) * (fan_in ** -0.5)

    def gain(shape, s=0.02):
        return 1.0 + s * jax.random.normal(next(ks), shape, jnp.float32)

    x = jax.random.normal(next(ks), (BATCH, SEQ, D_MODEL), jnp.float32)
    mem = jax.random.normal(next(ks), (BATCH, MEM_TOKENS, D_MODEL), jnp.float32)
    positions = (jnp.arange(SEQ, dtype=jnp.int32)[None, :]
                 + jax.random.randint(next(ks), (BATCH, 1), 0, 1024, dtype=jnp.int32))
    return {
        'x': x,
        'mem': mem,
        'positions': positions,
        'attn_norm_g': gain((L, D_MODEL)),
        'w_in': w((L, D_MODEL, IN_WIDTH), D_MODEL),
        'mla_q_a_norm_g': gain((L, Q_LORA_RANK)),
        'mla_w_uq': w((L, Q_LORA_RANK, MLA_HEADS * QK_HEAD_DIM), Q_LORA_RANK),
        'mla_kv_a_norm_g': gain((L, KV_LORA_RANK)),
        'mla_w_ukv': w((L, KV_LORA_RANK, MLA_HEADS * (QK_NOPE_DIM + V_HEAD_DIM)), KV_LORA_RANK),
        'mla_q_norm_g': gain((L, QK_HEAD_DIM)),
        'mla_k_norm_g': gain((L, QK_HEAD_DIM)),
        'mla_w_out': w((L, MLA_WIDTH, D_MODEL), MLA_WIDTH),
        'pool_w': w((L, POOL_GROUPS, POOL_GROUP_DIM, POOL_GROUP_DIM), POOL_GROUP_DIM),
        'pool_scale': gain((L, POOL_WIDTH), 0.1),
        'pool_w_out': w((L, POOL_WIDTH, D_MODEL), POOL_WIDTH),
        'mem_norm_g': gain((L, D_MODEL)),
        'mem_w_kv': w((L, D_MODEL, 2 * MEM_WIDTH), D_MODEL),
        'mem_q_norm_g': gain((L, MEM_HEAD_DIM)),
        'mem_k_norm_g': gain((L, MEM_HEAD_DIM)),
        'mem_w_out': w((L, MEM_WIDTH, D_MODEL), MEM_WIDTH),
        'w_o': w((L, D_MODEL, D_MODEL), D_MODEL),
        'ffn_norm_g': gain((L, D_MODEL)),
        'dense_w_gate': w((ND, D_MODEL, D_FF_DENSE), D_MODEL),
        'dense_w_up': w((ND, D_MODEL, D_FF_DENSE), D_MODEL),
        'dense_w_down': w((ND, D_FF_DENSE, D_MODEL), D_FF_DENSE),
        'router_w': w((NM, D_MODEL, N_EXPERTS), D_MODEL),
        'router_b': 0.01 * jax.random.normal(next(ks), (NM, N_EXPERTS), jnp.float32),
        'moe_w_gate': w((NM, N_EXPERTS, D_MODEL, D_FF_EXPERT), D_MODEL),
        'moe_w_up': w((NM, N_EXPERTS, D_MODEL, D_FF_EXPERT), D_MODEL),
        'moe_w_down': w((NM, N_EXPERTS, D_FF_EXPERT, D_MODEL), D_FF_EXPERT),
    }


def reference(x, mem, positions, attn_norm_g, w_in, mla_q_a_norm_g, mla_w_uq, mla_kv_a_norm_g,
              mla_w_ukv, mla_q_norm_g, mla_k_norm_g, mla_w_out, pool_w, pool_scale, pool_w_out,
              mem_norm_g, mem_w_kv, mem_q_norm_g, mem_k_norm_g, mem_w_out, w_o, ffn_norm_g,
              dense_w_gate, dense_w_up, dense_w_down, router_w, router_b, moe_w_gate, moe_w_up,
              moe_w_down):
    cos, sin = rope_tables(positions)
    y = x
    for l in range(DEPTH):
        h = rmsnorm(y, attn_norm_g[l])
        mem_n = rmsnorm(mem, mem_norm_g[l])
        y = y + token_mixer(h, mem_n, cos, sin, w_in[l], mla_q_a_norm_g[l], mla_w_uq[l],
                            mla_kv_a_norm_g[l], mla_w_ukv[l], mla_q_norm_g[l], mla_k_norm_g[l],
                            mla_w_out[l], pool_w[l], pool_scale[l], pool_w_out[l], mem_w_kv[l],
                            mem_q_norm_g[l], mem_k_norm_g[l], mem_w_out[l], w_o[l])
        h = rmsnorm(y, ffn_norm_g[l])
        i = l // 2
        if l % 2 == 0:
            y = y + dense_swiglu(h, dense_w_gate[i], dense_w_up[i], dense_w_down[i])
        else:
            y = y + moe_swiglu(h, router_w[i], router_b[i], moe_w_gate[i], moe_w_up[i], moe_w_down[i])
    return y
```

```cpp
#include <hip/hip_runtime.h>
#include <cstdio>
#include <cstdint>

#define LAS __attribute__((address_space(3)))
#define GAS __attribute__((address_space(1)))
typedef unsigned short bf16;
typedef short bf16x8 __attribute__((ext_vector_type(8)));
typedef float f32x4 __attribute__((ext_vector_type(4)));
typedef float f32x2 __attribute__((ext_vector_type(2)));
typedef float f32x16 __attribute__((ext_vector_type(16)));
typedef unsigned u32x4 __attribute__((ext_vector_type(4)));
typedef unsigned u32x2 __attribute__((ext_vector_type(2)));

#ifndef MK_PER_PHASE
#define MK_PER_PHASE 0
#endif

constexpr int T = 16384, DM = 2048, NB = 8, SEQ = 2048, NLAYER = 2;
constexpr int MEMT = 256, MROWS = NB * MEMT;
constexpr int ZW = 9216;
constexpr int ZC_POOL = 0, ZC_CQ = 1024, ZC_CKV = 1536, ZC_QM = 1792, ZC_KPE = 2816, ZC_GATE = 3072;
constexpr int ZNB = 1024, ZN8 = 8192;
constexpr float GATE_WSC = 128.f;
constexpr int INW = 9024;
constexpr int DFF = 5632, DFE = 7168, NEXP = 8;
constexpr int MAXTILES = 136, MAXSLOTS = MAXTILES * 256;
constexpr float EPS = 1e-6f;
constexpr float LOG2E = 1.4426950408889634f;
constexpr float MOE_WSC_UP = 128.f, MOE_WSC_DN = 256.f, MOE_GSC = 8.f;

constexpr size_t MiB = 1u << 20;
constexpr size_t WS_CTL = 0, CTL_ZERO_BYTES = 1 * MiB;
constexpr size_t WS_ROPE = 2 * MiB;
constexpr size_t WS_MOE = 6 * MiB;
constexpr size_t WS_W_IN = 8 * MiB;
constexpr size_t WS_W_IN8 = 32 * MiB;
constexpr size_t WS_H8 = 544 * MiB;
constexpr size_t WS_W_UQ = 80 * MiB;
constexpr size_t WS_W_UKV = 83 * MiB;
constexpr size_t WS_W_POOLOUT = 85 * MiB;
constexpr size_t WS_W_MLAOUT = 93 * MiB;
constexpr size_t WS_W_MEMOUT = 101 * MiB;
constexpr size_t WS_W_POOL = 109 * MiB;
constexpr size_t WS_W_MEMKV = 110 * MiB;
constexpr size_t WS_W_O = 126 * MiB;
constexpr size_t WS_W_DGU = 142 * MiB;
constexpr size_t WS_W_DD = 186 * MiB;
constexpr size_t WS_W_MGU = 208 * MiB;
constexpr size_t WS_W_MD = 432 * MiB;
constexpr size_t WS_H = 880 * MiB;
constexpr size_t WS_MEMN = 944 * MiB;
constexpr size_t WS_KM = 952 * MiB;
constexpr size_t WS_VMT = 956 * MiB;
constexpr size_t WS_R = 960 * MiB;
constexpr size_t WS_Z = WS_R;
constexpr size_t WS_QB = WS_R + 288 * MiB;
constexpr size_t WS_KNOPE = WS_R + 336 * MiB;
constexpr size_t WS_KB = WS_R + 368 * MiB;
constexpr size_t WS_VT = WS_R + 416 * MiB;
constexpr size_t WS_POOLED = WS_R + 448 * MiB;
constexpr size_t WS_MIXED = WS_R + 480 * MiB;
constexpr size_t WS_OMLA = WS_R + 512 * MiB;
constexpr size_t WS_OMEM = WS_R + 544 * MiB;
constexpr size_t WS_MACC = WS_R + 576 * MiB;
constexpr size_t WS_MERGED = WS_R + 704 * MiB;
constexpr size_t WS_G = WS_R;
constexpr size_t WS_XG = WS_R;
constexpr size_t WS_GM = WS_R + 68 * MiB;
constexpr size_t WS_YS = WS_R + 306 * MiB;
constexpr size_t WS_END = WS_R + 768 * MiB;
constexpr size_t MO_TOKE = 0;
constexpr size_t MO_TOKW = 128 * 1024;
constexpr size_t MO_TOKS = 256 * 1024;
constexpr size_t MO_HIST = 384 * 1024;
constexpr size_t MO_TILEE = 400 * 1024;
constexpr size_t MO_RS = 512 * 1024;
constexpr size_t MO_RQ = 1024 * 1024;
constexpr int CW_BAR = 4096;

constexpr int RING_BYTES = 131072;
constexpr int LDSCTL_OFF = RING_BYTES, MISC_OFF = LDSCTL_OFF + 320;
constexpr int LDS_BYTES = 147456;
constexpr int TILEE_OFF = LDSCTL_OFF + 2048;
constexpr int TBL_OFF = LDSCTL_OFF + 1024;

__device__ __forceinline__ unsigned cvt_pk_bf16(float lo, float hi) { unsigned r; asm volatile("v_cvt_pk_bf16_f32 %0, %1, %2" : "=v"(r) : "v"(lo), "v"(hi)); return r; }
__device__ __forceinline__ float bf_lo(unsigned w) { return __uint_as_float(w << 16); }
__device__ __forceinline__ float bf_hi(unsigned w) { return __uint_as_float(w & 0xffff0000u); }
__device__ __forceinline__ float wave_sum(float v) {
#pragma unroll
    for (int o = 1; o < 64; o <<= 1) v += __shfl_xor(v, o);
    return v;
}
__device__ __forceinline__ float fast_sigmoid(float x) { return __builtin_amdgcn_rcpf(1.0f + __builtin_amdgcn_exp2f(-x * LOG2E)); }
__device__ __forceinline__ int ld_agent_i(const int* p) { return (int)__hip_atomic_load((const unsigned*)p, __ATOMIC_RELAXED, __HIP_MEMORY_SCOPE_AGENT); }
__device__ __forceinline__ int launder_i(int x) { asm volatile("" : "+v"(x)); return x; }
__device__ __forceinline__ const void* ld_tbl(LAS unsigned char* lds, int i) { const LAS unsigned* t = (const LAS unsigned*)(lds + TBL_OFF) + 2 * i; const unsigned lo = __builtin_amdgcn_readfirstlane(t[0]), hi = __builtin_amdgcn_readfirstlane(t[1]);
    return (const void*)(GAS const void*)(((unsigned long long)hi << 32) | lo); }
#define INF(i) ((const float*)ld_tbl(lds, (i)))
#define LDS_WAIT() asm volatile("s_waitcnt lgkmcnt(0)" ::: "memory")
#define VM_WAIT() asm volatile("s_waitcnt vmcnt(0)" ::: "memory")

namespace pg8 {
constexpr int BM = 256, BK = 64, HALF = 128, HTB = HALF * BK * 2, STAGE_BYTES = 8 * HTB, NXCD = 8, WGM = 8;
__host__ __device__ __forceinline__ int lds_byte(int r, int c) { const int st = (r >> 4) * 2 + (c >> 5), rr = r & 15, cc = c & 31, ob = rr * 64 + cc * 2; return st * 1024 + (ob ^ (((ob >> 9) & 1) << 5)); }
__host__ __device__ __forceinline__ void stage_rc(int b, int& R, int& C) { const int st = b / 1024, sb = b % 1024, swz = sb ^ (((sb >> 9) & 1) << 5); R = (st >> 1) * 16 + swz / 64; C = (st & 1) * 32 + (swz % 64) / 2; }
__host__ __device__ __forceinline__ int perm32(int rho) { const int n = rho >> 4, i = rho & 15; return 8 * (i >> 2) + 4 * n + (i & 3); }

struct Unit { int pm, pn, sub; };
struct StaticOrder {
    int nM, nN, nwg, G, c;
    __device__ void init(int nM_, int nN_, int G_, int c_) { nM = nM_; nN = nN_; nwg = nM * nN; G = G_; c = c_; }
    __device__ bool next(int i, Unit& u) const {
        const long L = (long)i * G + c; if (L >= nwg) return false;
        int wgid = (int)L; { const int q = nwg / NXCD, r = nwg % NXCD, xcd = wgid % NXCD, off = wgid / NXCD; wgid = (xcd < r ? xcd * (q + 1) : r * (q + 1) + (xcd - r) * q) + off; }
        const int nig = WGM * nN, gid = wgid / nig, fm = gid * WGM, gsz = (nM - fm) < WGM ? (nM - fm) : WGM;
        u.pm = fm + ((wgid % nig) % gsz); u.pn = (wgid % nig) / gsz; u.sub = 0; return true;
    }
};
struct Sched {
    StaticOrder so;
    const char* A; const char* B;
    size_t a_tile, b_tile, a_pn, b_exp;
    const LAS int* tile_e;
    __device__ __forceinline__ bool next(int i, Unit& u) const { return so.next(i, u); }
    __device__ __forceinline__ void ptrs(const Unit& u, const char*& cA, const char*& cB) const {
        int e = 0; if (tile_e) e = __builtin_amdgcn_readfirstlane(tile_e[u.pm]);
        cA = A + (size_t)u.pm * a_tile + (size_t)u.pn * a_pn; cB = B + (size_t)e * b_exp + (size_t)u.pn * b_tile;
    }
};
__device__ __forceinline__ Sched make_sched(const bf16* A, int lda, const bf16* Bt, int ldb, int nM, int nN, int G, int c) {
    Sched s; s.so.init(nM, nN, G, c); s.A = (const char*)A; s.B = (const char*)Bt; s.a_tile = (size_t)256 * lda * 2; s.b_tile = (size_t)256 * ldb * 2; s.a_pn = 0; s.b_exp = 0; s.tile_e = nullptr; return s;
}

struct SchedChain3 {
    StaticOrder so;
    const char* A; const char* B;
    size_t a_tile, b_tile, a_sub, b_sub;
    __device__ __forceinline__ bool next(int i, Unit& u) const { const bool ok = so.next(i / 3, u); u.sub = i % 3; return ok; }
    __device__ __forceinline__ void ptrs(const Unit& u, const char*& cA, const char*& cB) const {
        cA = A + (size_t)u.sub * a_sub + (size_t)u.pm * a_tile; cB = B + (size_t)u.sub * b_sub + (size_t)u.pn * b_tile;
    }
};
typedef int i32x8 __attribute__((ext_vector_type(8)));
typedef int i32x4 __attribute__((ext_vector_type(4)));
__device__ __forceinline__ i32x8 cat8(bf16x8 a, bf16x8 b) { const i32x4 x = __builtin_bit_cast(i32x4, a), y = __builtin_bit_cast(i32x4, b); return (i32x8){x[0], x[1], x[2], x[3], y[0], y[1], y[2], y[3]}; }
__device__ __forceinline__ void mfma8(f32x4& acc, i32x8 a, i32x8 b, int sc) { asm volatile("v_mfma_scale_f32_16x16x128_f8f6f4 %0, %1, %2, %0, %3, %3 op_sel_hi:[0,0,0]" : "+v"(acc) : "v"(a), "v"(b), "v"(sc)); }
template <class Epi, bool ALIGN_EPI, bool FP8 = false, class Sch = Sched>
__device__ __forceinline__ void gemm_phase(LAS unsigned char* lds, const int K, const int lda, const int ldb, const Sch& S, const Epi& E) {
    const int tid = launder_i(threadIdx.x), wid = __builtin_amdgcn_readfirstlane(tid >> 6), lane = tid & 63, wr = wid >> 2, wc = wid & 3, fr = lane & 15, fq = lane >> 4;
    const int nt = K / BK;
    unsigned voffA[2], voffB[2];
#pragma unroll
    for (int i = 0; i < 2; ++i) { int R, C; stage_rc(tid * 16 + i * 8192, R, C); const int Rb = (R & ~31) + perm32(R & 31);
        voffA[i] = (unsigned)(R * lda + C) * 2u; voffB[i] = (unsigned)(Rb * ldb + C) * 2u; }
    const size_t kstep = (size_t)(BK * 2);
    const size_t hstepA = (size_t)HALF * lda * 2, hstepB = (size_t)HALF * ldb * 2;
    const unsigned ldsw = (unsigned)wid * 1024u;
    const int aoff = lds_byte(wr * 64 + fr, fq * 8), boff = lds_byte(wc * 32 + fr, fq * 8);
#define PG8_SA(b, h) (((b) * 2 + (h)) * HTB)
#define PG8_SB(b, h) ((4 + (b) * 2 + (h)) * HTB)
#define PG8_STAGE(bufoff, gbase, voff) do { _Pragma("unroll") for (int _i = 0; _i < 2; ++_i) \
        __builtin_amdgcn_global_load_lds((const unsigned*)((const char*)(gbase) + (voff)[_i]), (LAS unsigned*)(lds + (bufoff) + ldsw + _i * 8192), 16, 0, 0); } while (0)
#define PG8_LDA(dst, b, h) do { _Pragma("unroll") for (int m = 0; m < 4; ++m) _Pragma("unroll") for (int k = 0; k < 2; ++k) dst[m][k] = *(const LAS bf16x8*)(lds + PG8_SA(b, h) + aoff + m * 2048 + k * 1024); } while (0)
#define PG8_LDB(dst, b, h) do { _Pragma("unroll") for (int n = 0; n < 2; ++n) _Pragma("unroll") for (int k = 0; k < 2; ++k) dst[n][k] = *(const LAS bf16x8*)(lds + PG8_SB(b, h) + boff + n * 2048 + k * 1024); } while (0)
#define PG8_MMA(ai, bj, At, Bt) do { __builtin_amdgcn_s_setprio(1); _Pragma("unroll") for (int m = 0; m < 4; ++m) _Pragma("unroll") for (int n = 0; n < 2; ++n) { \
        if constexpr (FP8) mfma8(acc[ai][bj][m][n], cat8(Bt[n][0], Bt[n][1]), cat8(At[m][0], At[m][1]), one_scale); \
        else { _Pragma("unroll") for (int k = 0; k < 2; ++k) acc[ai][bj][m][n] = __builtin_amdgcn_mfma_f32_16x16x32_bf16(Bt[n][k], At[m][k], acc[ai][bj][m][n], 0, 0, 0); } } \
        __builtin_amdgcn_s_setprio(0); } while (0)
#define PG8_WAIT_V(n) asm volatile("s_waitcnt vmcnt(" #n ")" ::: "memory")
#define PG8_WAIT_L(n) asm volatile("s_waitcnt lgkmcnt(" #n ")" ::: "memory")
#define PG8_BAR __builtin_amdgcn_s_barrier()
#define PG8_SCHED __builtin_amdgcn_sched_barrier(0)
    Unit cur, nxt; int ui = 0;
    if (!S.next(0, cur)) return;
    f32x4 acc[2][2][4][2];
#pragma unroll
    for (int a = 0; a < 2; ++a)
#pragma unroll
        for (int b = 0; b < 2; ++b)
#pragma unroll
            for (int m = 0; m < 4; ++m)
#pragma unroll
                for (int n = 0; n < 2; ++n) acc[a][b][m][n] = (f32x4){0.f, 0.f, 0.f, 0.f};
    bf16x8 At[4][2], B0[2][2], B1[2][2];
    int one_scale = 0x7F7F7F7F; asm volatile("" : "+v"(one_scale));
    const char* cA; const char* cB; S.ptrs(cur, cA, cB);
    PG8_STAGE(PG8_SB(0, 0), cB, voffB); PG8_STAGE(PG8_SB(0, 1), cB + hstepB, voffB); PG8_STAGE(PG8_SA(0, 0), cA, voffA); PG8_STAGE(PG8_SA(0, 1), cA + hstepA, voffA);
    if (wr == 1) PG8_BAR;
    PG8_WAIT_V(2); PG8_BAR;
    PG8_STAGE(PG8_SB(1, 0), cB + kstep, voffB); PG8_STAGE(PG8_SA(1, 0), cA + kstep, voffA); PG8_STAGE(PG8_SB(1, 1), cB + hstepB + kstep, voffB);
    PG8_WAIT_V(6); PG8_BAR;
    for (;;) {
        const bool has_next = S.next(ui + 1, nxt);
        const char* nA = cA; const char* nB = cB; if (has_next) S.ptrs(nxt, nA, nB);
#pragma unroll 1
        for (int t = 0; t < nt; t += 2) {
            const bool last = (t == nt - 2);
            const char* a1 = cA + (size_t)(t + 1) * kstep;
            const char* a2 = last ? nA : cA + (size_t)(t + 2) * kstep; const char* b2 = last ? nB : cB + (size_t)(t + 2) * kstep;
            const char* a3 = a2 + kstep; const char* b3 = b2 + kstep;
            PG8_LDB(B0, 0, 0); PG8_LDB(B1, 0, 1); PG8_SCHED; PG8_LDA(At, 0, 0); PG8_STAGE(PG8_SA(1, 1), a1 + hstepA, voffA);
            PG8_WAIT_V(8); PG8_WAIT_L(0); PG8_BAR; PG8_MMA(0, 0, At, B0); PG8_MMA(0, 1, At, B1); PG8_BAR; PG8_SCHED;
            PG8_LDA(At, 0, 1); PG8_STAGE(PG8_SB(0, 0), b2, voffB); PG8_STAGE(PG8_SB(0, 1), b2 + hstepB, voffB); PG8_STAGE(PG8_SA(0, 0), a2, voffA);
            PG8_WAIT_V(8); PG8_WAIT_L(0); PG8_BAR; PG8_MMA(1, 0, At, B0); PG8_MMA(1, 1, At, B1); PG8_BAR; PG8_SCHED;
            PG8_LDB(B0, 1, 0); PG8_LDB(B1, 1, 1); PG8_SCHED; PG8_LDA(At, 1, 0); PG8_STAGE(PG8_SA(0, 1), a2 + hstepA, voffA);
            PG8_WAIT_V(8); PG8_WAIT_L(0); PG8_BAR; PG8_MMA(0, 0, At, B0); PG8_MMA(0, 1, At, B1); PG8_BAR; PG8_SCHED;
            PG8_LDA(At, 1, 1); PG8_STAGE(PG8_SB(1, 0), b3, voffB); PG8_STAGE(PG8_SB(1, 1), b3 + hstepB, voffB); PG8_STAGE(PG8_SA(1, 0), a3, voffA);
            PG8_WAIT_V(8); PG8_WAIT_L(0); PG8_BAR; PG8_MMA(1, 0, At, B0); PG8_MMA(1, 1, At, B1); PG8_BAR; PG8_SCHED;
        }
        if constexpr (ALIGN_EPI) { if (wr == 0) PG8_BAR; }
        if constexpr (FP8) asm volatile("s_nop 7\n\ts_nop 7" ::: "memory");
        E(acc, cur, wr, wc, fr, fq);
        if (!has_next) break;
        if (Epi::CHAIN == 0 || cur.sub == Epi::CHAIN - 1)
#pragma unroll
        for (int a = 0; a < 2; ++a)
#pragma unroll
            for (int b = 0; b < 2; ++b)
#pragma unroll
                for (int m = 0; m < 4; ++m)
#pragma unroll
                    for (int n = 0; n < 2; ++n) acc[a][b][m][n] = (f32x4){0.f, 0.f, 0.f, 0.f};
        cur = nxt; cA = nA; cB = nB; ++ui;
        if constexpr (ALIGN_EPI) { if (wr == 1) PG8_BAR; }
    }
    PG8_WAIT_V(0);
    if constexpr (!ALIGN_EPI) { if (wr == 0) PG8_BAR; }
    PG8_BAR;
#undef PG8_SA
#undef PG8_SB
#undef PG8_STAGE
#undef PG8_LDA
#undef PG8_LDB
#undef PG8_MMA
#undef PG8_WAIT_V
#undef PG8_WAIT_L
#undef PG8_BAR
#undef PG8_SCHED
}

template <int ACT> struct EpiBf16 {
    static constexpr int CHAIN = 0;
    bf16* O; int ldc; int act_lo, act_hi; const float* scale; float cmul;
    __device__ __forceinline__ void operator()(f32x4 (&acc)[2][2][4][2], const Unit& u, int wr, int wc, int fr, int fq) const {
        const int row0 = u.pm * BM + wr * 64 + fr, col0 = u.pn * BM + wc * 32 + 8 * fq;
        const bool sg = (ACT == 1) && u.pn >= act_lo && u.pn < act_hi;
        f32x4 sv[2][2];
        if (ACT == 2) {
#pragma unroll
            for (int bj = 0; bj < 2; ++bj)
#pragma unroll
                for (int n = 0; n < 2; ++n) sv[bj][n] = *(const f32x4*)(scale + col0 + bj * HALF + 4 * n);
        }
#pragma unroll
        for (int ai = 0; ai < 2; ++ai)
#pragma unroll
            for (int m = 0; m < 4; ++m) { bf16* rowp = O + (size_t)(row0 + ai * HALF + m * 16) * ldc + col0;
#pragma unroll
                for (int bj = 0; bj < 2; ++bj) { f32x4 v0 = acc[ai][bj][m][0], v1 = acc[ai][bj][m][1];
                    if (ACT == 1) { if (sg) {
#pragma unroll
                        for (int j = 0; j < 4; ++j) { v0[j] = fast_sigmoid(v0[j] * cmul); v1[j] = fast_sigmoid(v1[j] * cmul); } } else { v0 = v0 * cmul; v1 = v1 * cmul; } }
                    if (ACT == 2) { v0 = v0 * sv[bj][0]; v1 = v1 * sv[bj][1]; }
                    if (ACT == 3) { v0 = v0 * cmul; v1 = v1 * cmul; }
                    if (ACT == 4) { const float rsc = scale[row0 + ai * HALF + m * 16]; v0 = v0 * rsc; v1 = v1 * rsc; }
                    u32x4 w; w.x = cvt_pk_bf16(v0[0], v0[1]); w.y = cvt_pk_bf16(v0[2], v0[3]); w.z = cvt_pk_bf16(v1[0], v1[1]); w.w = cvt_pk_bf16(v1[2], v1[3]);
                    *(u32x4*)(rowp + bj * HALF) = w; } }
    }
};
template <int MODE> struct EpiGate {
    static constexpr int CHAIN = 0;
    const bf16* gate; int ldg; float* macc; bf16* out; int ldc;
    __device__ __forceinline__ void operator()(f32x4 (&acc)[2][2][4][2], const Unit& u, int wr, int wc, int fr, int fq) const {
        const int row0 = u.pm * BM + wr * 64 + fr, col0 = u.pn * BM + wc * 32 + 8 * fq;
#pragma unroll
        for (int ai = 0; ai < 2; ++ai)
#pragma unroll
            for (int m = 0; m < 4; ++m) { const size_t row = (size_t)(row0 + ai * HALF + m * 16);
#pragma unroll
                for (int bj = 0; bj < 2; ++bj) { const int col = col0 + bj * HALF;
                    const u32x4 g = *(const u32x4*)(gate + row * ldg + col);
                    f32x4 v0 = acc[ai][bj][m][0], v1 = acc[ai][bj][m][1];
                    v0[0] *= bf_lo(g.x); v0[1] *= bf_hi(g.x); v0[2] *= bf_lo(g.y); v0[3] *= bf_hi(g.y);
                    v1[0] *= bf_lo(g.z); v1[1] *= bf_hi(g.z); v1[2] *= bf_lo(g.w); v1[3] *= bf_hi(g.w);
                    float* mp = macc + row * ldc + col;
                    if (MODE >= 1) { v0 = v0 + *(const f32x4*)mp; v1 = v1 + *(const f32x4*)(mp + 4); }
                    if (MODE <= 1) { *(f32x4*)mp = v0; *(f32x4*)(mp + 4) = v1; }
                    else { u32x4 w; w.x = cvt_pk_bf16(v0[0], v0[1]); w.y = cvt_pk_bf16(v0[2], v0[3]); w.z = cvt_pk_bf16(v1[0], v1[1]); w.w = cvt_pk_bf16(v1[2], v1[3]);
                        *(u32x4*)(out + row * ldc + col) = w; } } }
    }
};
struct EpiChain3 {
    static constexpr int CHAIN = 3;
    const bf16* gate; int ldg; int gstride; bf16* out; int ldc;
    __device__ __forceinline__ void operator()(f32x4 (&acc)[2][2][4][2], const Unit& u, int wr, int wc, int fr, int fq) const {
        const int row0 = u.pm * BM + wr * 64 + fr, col0 = u.pn * BM + wc * 32 + 8 * fq;
#pragma unroll
        for (int ai = 0; ai < 2; ++ai)
#pragma unroll
            for (int m = 0; m < 4; ++m) { const size_t row = (size_t)(row0 + ai * HALF + m * 16);
#pragma unroll
                for (int bj = 0; bj < 2; ++bj) { const int col = col0 + bj * HALF;
                    const bf16* gp = gate + row * ldg + (size_t)u.sub * gstride + col;
                    const u32x4 g = *(const u32x4*)gp; const u32x4 h = *(const u32x4*)(gp + (u.sub < 2 ? gstride : 0));
                    f32x4 fa = {bf_lo(g.x), bf_hi(g.x), bf_lo(g.y), bf_hi(g.y)}, fb = {bf_lo(g.z), bf_hi(g.z), bf_lo(g.w), bf_hi(g.w)};
                    f32x4 da = {bf_lo(h.x), bf_hi(h.x), bf_lo(h.y), bf_hi(h.y)}, db = {bf_lo(h.z), bf_hi(h.z), bf_lo(h.w), bf_hi(h.w)};
#pragma unroll
                    for (int j = 0; j < 4; ++j) { fa[j] = fmaxf(fa[j], 1e-20f); fb[j] = fmaxf(fb[j], 1e-20f);
                        const float ra = __builtin_amdgcn_rcpf(fmaxf(da[j], 1e-20f)), rb = __builtin_amdgcn_rcpf(fmaxf(db[j], 1e-20f));
                        fa[j] = (u.sub < 2) ? fa[j] * ra : fa[j]; fb[j] = (u.sub < 2) ? fb[j] * rb : fb[j]; }
                    f32x4 v0 = acc[ai][bj][m][0], v1 = acc[ai][bj][m][1];
                    v0 = v0 * fa; v1 = v1 * fb;
                    if (u.sub < 2) { acc[ai][bj][m][0] = v0; acc[ai][bj][m][1] = v1; }
                    else { u32x4 w; w.x = cvt_pk_bf16(v0[0], v0[1]); w.y = cvt_pk_bf16(v0[2], v0[3]); w.z = cvt_pk_bf16(v1[0], v1[1]); w.w = cvt_pk_bf16(v1[2], v1[3]);
                        *(u32x4*)(out + row * ldc + col) = w; } } }
    }
};
struct EpiResid {
    static constexpr int CHAIN = 0;
    const float* base; float* out; int ldc;
    __device__ __forceinline__ void operator()(f32x4 (&acc)[2][2][4][2], const Unit& u, int wr, int wc, int fr, int fq) const {
        const int row0 = u.pm * BM + wr * 64 + fr, col0 = u.pn * BM + wc * 32 + 8 * fq;
#pragma unroll
        for (int ai = 0; ai < 2; ++ai)
#pragma unroll
            for (int m = 0; m < 4; ++m) { const size_t off = (size_t)(row0 + ai * HALF + m * 16) * ldc + col0;
#pragma unroll
                for (int bj = 0; bj < 2; ++bj) { const float* bp = base + off + bj * HALF; float* op = out + off + bj * HALF;
                    const f32x4 b0 = *(const f32x4*)bp, b1 = *(const f32x4*)(bp + 4);
                    *(f32x4*)op = b0 + acc[ai][bj][m][0]; *(f32x4*)(op + 4) = b1 + acc[ai][bj][m][1]; } }
    }
};
struct EpiSwiGLU {
    static constexpr int CHAIN = 0;
    bf16* O; int ldc;
    __device__ __forceinline__ void operator()(f32x4 (&acc)[2][2][4][2], const Unit& u, int wr, int wc, int fr, int fq) const {
        const int row0 = u.pm * BM + wr * 64 + fr, col0 = u.pn * HALF + wc * 32 + 8 * fq;
#pragma unroll
        for (int ai = 0; ai < 2; ++ai)
#pragma unroll
            for (int m = 0; m < 4; ++m) { bf16* rowp = O + (size_t)(row0 + ai * HALF + m * 16) * ldc + col0;
                f32x4 r[2];
#pragma unroll
                for (int n = 0; n < 2; ++n) { const f32x4 g = acc[ai][0][m][n], up = acc[ai][1][m][n];
#pragma unroll
                    for (int j = 0; j < 4; ++j) r[n][j] = g[j] * fast_sigmoid(g[j]) * up[j]; }
                u32x4 w; w.x = cvt_pk_bf16(r[0][0], r[0][1]); w.y = cvt_pk_bf16(r[0][2], r[0][3]); w.z = cvt_pk_bf16(r[1][0], r[1][1]); w.w = cvt_pk_bf16(r[1][2], r[1][3]);
                *(u32x4*)rowp = w; }
    }
};
struct EpiSwiGLU8 {
    static constexpr int CHAIN = 0;
    unsigned char* O; int ldc; float imul, omul;
    __device__ __forceinline__ void operator()(f32x4 (&acc)[2][2][4][2], const Unit& u, int wr, int wc, int fr, int fq) const {
        const int row0 = u.pm * BM + wr * 64 + fr, col0 = u.pn * HALF + wc * 32 + 8 * fq;
#pragma unroll
        for (int ai = 0; ai < 2; ++ai)
#pragma unroll
            for (int m = 0; m < 4; ++m) { unsigned char* rowp = O + (size_t)(row0 + ai * HALF + m * 16) * ldc + col0;
                float r[8];
#pragma unroll
                for (int n = 0; n < 2; ++n) { const f32x4 g = acc[ai][0][m][n] * imul, up = acc[ai][1][m][n] * (imul * omul);
#pragma unroll
                    for (int j = 0; j < 4; ++j) r[4 * n + j] = __builtin_amdgcn_fmed3f(g[j] * fast_sigmoid(g[j]) * up[j], -440.f, 440.f); }
                int w0 = 0, w1 = 0;
                w0 = __builtin_amdgcn_cvt_pk_fp8_f32(r[0], r[1], w0, false); w0 = __builtin_amdgcn_cvt_pk_fp8_f32(r[2], r[3], w0, true);
                w1 = __builtin_amdgcn_cvt_pk_fp8_f32(r[4], r[5], w1, false); w1 = __builtin_amdgcn_cvt_pk_fp8_f32(r[6], r[7], w1, true);
                *(u32x2*)rowp = (u32x2){(unsigned)w0, (unsigned)w1}; }
    }
};
}

#define XB_TMO      128
#define XB_XCNT(j)  (256  + 64 * (j))
#define XB_XSUB(j)  (1280 + 64 * (j))
#define XB_XGEN(j)  (2304 + 64 * (j))
#define XB_TOP      3328
#define XB_TOPGEN   3392
#define XCD_BAR_WORDS 3456
#define XB_SPIN_CAP (1u << 20)
__device__ __forceinline__ unsigned xb_ld(unsigned* p)              { return __hip_atomic_load(p, __ATOMIC_RELAXED, __HIP_MEMORY_SCOPE_AGENT); }
__device__ __forceinline__ unsigned xb_add(unsigned* p, unsigned v) { return __hip_atomic_fetch_add(p, v, __ATOMIC_RELAXED, __HIP_MEMORY_SCOPE_AGENT); }
__device__ __forceinline__ unsigned xb_xcc_id() { return (unsigned)__builtin_amdgcn_s_getreg((3 << 11) | 20) & 0xFu; }
#define XB_SPIN(cond, bar) do { unsigned _sp = 0; while (cond) { __builtin_amdgcn_s_sleep(1); \
    if ((++_sp & 255u) == 0u) { if (xb_ld(&(bar)[XB_TMO])) break; if (_sp > XB_SPIN_CAP) { atomicAdd(&(bar)[XB_TMO], 1u); break; } } } } while (0)
struct XcdBarrier { unsigned* bar; unsigned x; volatile LAS unsigned* st; };
__device__ __forceinline__ XcdBarrier xcd_barrier_post(unsigned* bar, volatile LAS unsigned* st) {
    XcdBarrier b; b.bar = bar; b.x = xb_xcc_id(); b.st = st;
    if (threadIdx.x == 0) (void)xb_add(&bar[XB_XCNT(b.x)], 1u);
    return b;
}
__device__ __forceinline__ void xcd_barrier_complete(unsigned* bar, unsigned x, unsigned& nloc, unsigned& nx) {
    const unsigned G = gridDim.x * gridDim.y * gridDim.z;
    unsigned sum, cnt, mine, sp = 0u;
    for (;;) {
        sum = 0u; cnt = 0u; mine = 0u;
#pragma unroll
        for (unsigned j = 0; j < 16; ++j) { const unsigned c = xb_ld(&bar[XB_XCNT(j)]); sum += c; cnt += (c > 0u) ? 1u : 0u; mine = (j == x) ? c : mine; }
        if (sum == G) break;
        __builtin_amdgcn_s_sleep(1);
        if ((++sp & 255u) == 0u) { if (xb_ld(&bar[XB_TMO])) break; if (sp > XB_SPIN_CAP) { atomicAdd(&bar[XB_TMO], 1u); break; } }
    }
    nloc = mine > 0u ? mine : 1u; nx = cnt > 0u ? cnt : 1u;
}
__device__ __forceinline__ void xcd_barrier(const XcdBarrier& b) {
    asm volatile("s_waitcnt vmcnt(0)" ::: "memory");
    __syncthreads();
    if (threadIdx.x == 0) {
        unsigned* bar = b.bar;
        __builtin_amdgcn_s_waitcnt(0);
        unsigned nloc = b.st[0], nx = b.st[1];
        if (nloc == 0u) { xcd_barrier_complete(bar, b.x, nloc, nx); b.st[0] = nloc; b.st[1] = nx; }
        const unsigned old = xb_add(&bar[XB_XSUB(b.x)], 1u);
        const unsigned gen = old / nloc;
        if (old + 1u == (gen + 1u) * nloc) {
            __builtin_amdgcn_fence(__ATOMIC_RELEASE, "agent");
            asm volatile("s_waitcnt vmcnt(0)" ::: "memory");
            const unsigned og = xb_add(&bar[XB_TOP], 1u);
            const unsigned tg = og / nx;
            if (og + 1u == (tg + 1u) * nx) xb_add(&bar[XB_TOPGEN], 1u);
            else XB_SPIN(xb_ld(&bar[XB_TOPGEN]) == tg, bar);
            __builtin_amdgcn_fence(__ATOMIC_ACQUIRE, "agent");
            xb_add(&bar[XB_XGEN(b.x)], 1u);
            asm volatile("s_waitcnt vmcnt(0)" ::: "memory");
        } else {
            XB_SPIN(xb_ld(&bar[XB_XGEN(b.x)]) == gen, bar);
            __builtin_amdgcn_fence(__ATOMIC_ACQUIRE, "agent");
            asm volatile("s_waitcnt vmcnt(0)" ::: "memory");
        }
    }
    __syncthreads();
}

__device__ __forceinline__ unsigned f2bf(float f) { unsigned u = __builtin_bit_cast(unsigned, f); return (u + 0x7fffu + ((u >> 16) & 1u)) >> 16; }
__device__ __forceinline__ unsigned pk2(float lo, float hi) { return f2bf(lo) | (f2bf(hi) << 16); }
__device__ __forceinline__ void conv_item(const float* W, int ldw, int k0, int n0, bf16* WT, int K, int drow, LAS float* scr, int lane, const float* gk = nullptr) {
#pragma unroll
    for (int i = 0; i < 8; ++i) { const int kk = i * 8 + (lane >> 3), n4 = (lane & 7) * 4;
        f32x4 v = *(const f32x4*)(W + (size_t)(k0 + kk) * ldw + n0 + n4); if (gk) v = v * gk[k0 + kk];
        scr[kk * 33 + n4 + 0] = v[0]; scr[kk * 33 + n4 + 1] = v[1]; scr[kk * 33 + n4 + 2] = v[2]; scr[kk * 33 + n4 + 3] = v[3]; }
    LDS_WAIT(); asm volatile("" ::: "memory");
    const int c = lane & 7;
#pragma unroll
    for (int j = 0; j < 4; ++j) { const int n = (lane >> 3) + 8 * j; const LAS float* s = scr + (8 * c) * 33 + n;
        u32x4 o; o.x = pk2(s[0 * 33], s[1 * 33]); o.y = pk2(s[2 * 33], s[3 * 33]); o.z = pk2(s[4 * 33], s[5 * 33]); o.w = pk2(s[6 * 33], s[7 * 33]);
        *(u32x4*)(WT + (size_t)(drow + n) * K + k0 + 8 * c) = o; }
    LDS_WAIT(); asm volatile("" ::: "memory");
}
__device__ __forceinline__ void conv_item8(const float* W, int ldw, int k0, int n0, unsigned char* WT, int Kb, int drow, float sc, LAS float* scr, int lane) {
#pragma unroll
    for (int i = 0; i < 8; ++i) { const int kk = i * 8 + (lane >> 3), n4 = (lane & 7) * 4;
        const f32x4 v = *(const f32x4*)(W + (size_t)(k0 + kk) * ldw + n0 + n4);
        scr[kk * 33 + n4 + 0] = v[0]; scr[kk * 33 + n4 + 1] = v[1]; scr[kk * 33 + n4 + 2] = v[2]; scr[kk * 33 + n4 + 3] = v[3]; }
    LDS_WAIT(); asm volatile("" ::: "memory");
    const int c = lane & 7;
#pragma unroll
    for (int j = 0; j < 4; ++j) { const int n = (lane >> 3) + 8 * j; const LAS float* s = scr + (8 * c) * 33 + n;
        int w0 = 0, w1 = 0;
        w0 = __builtin_amdgcn_cvt_pk_fp8_f32(s[0 * 33] * sc, s[1 * 33] * sc, w0, false); w0 = __builtin_amdgcn_cvt_pk_fp8_f32(s[2 * 33] * sc, s[3 * 33] * sc, w0, true);
        w1 = __builtin_amdgcn_cvt_pk_fp8_f32(s[4 * 33] * sc, s[5 * 33] * sc, w1, false); w1 = __builtin_amdgcn_cvt_pk_fp8_f32(s[6 * 33] * sc, s[7 * 33] * sc, w1, true);
        *(u32x2*)(WT + (size_t)(drow + n) * Kb + k0 + 8 * c) = (u32x2){(unsigned)w0, (unsigned)w1}; }
    LDS_WAIT(); asm volatile("" ::: "memory");
}
__device__ __forceinline__ int map_win8(int n0) {
    if (n0 < 768) return n0; if (n0 < 832) return (ZC_KPE - ZC_CQ) + (n0 - 768); if (n0 < 2880) return (ZC_QM - ZC_CQ) + (n0 - 1856);
    const int gb = ZC_GATE - ZC_CQ; if (n0 < 4928) return gb + 2048 + (n0 - 2880); if (n0 < 6976) return gb + (n0 - 4928); return gb + 4096 + (n0 - 6976); }
__device__ __forceinline__ int map_ukv(int n0) { const int h = n0 >> 8, j0 = n0 & 255; return j0 < 128 ? h * 128 + j0 : 1024 + h * 128 + (j0 - 128); }
__device__ __forceinline__ int map_gu(int n0, int up) { return (n0 >> 7) * 256 + up * 128 + (n0 & 127); }

struct Args { const void* in[30]; float* out; unsigned char* ws; int ph_lo, ph_hi; };

__device__ __forceinline__ void p_prologue(LAS unsigned char* lds, int gw, int NGW, int wave, int lane) {
    LAS float* scr = (LAS float*)(lds + wave * 16384);
    unsigned char* ws = (unsigned char*)ld_tbl(lds, 31);
    constexpr int I_IN = 32 * 282, I_UQ = 8 * 48, I_UKV = 4 * 64, I_MO = 16 * 64, I_PW = 4 * 8, I_MKV = 32 * 64, I_WO = 32 * 64;
    constexpr int I_DG = 32 * 176, I_DD = 88 * 64, I_MG = 32 * 224, I_MDN = 112 * 64;
    constexpr long NITEMS = 2L * (I_IN + I_UQ + I_UKV + I_MO + 4 * I_PW + I_MO + I_MKV + I_MO + I_WO) + 2 * I_DG + I_DD + 8L * (2 * I_MG + I_MDN);
    unsigned* ticket = (unsigned*)(ws + WS_CTL) + 64;
    for (;;) { unsigned tk = 0; if (lane == 0) tk = __hip_atomic_fetch_add(ticket, 1u, __ATOMIC_RELAXED, __HIP_MEMORY_SCOPE_AGENT);
      const long it0 = 8L * (long)__builtin_amdgcn_readfirstlane((int)tk);
      if (it0 >= NITEMS) break;
      for (long it = it0; it < it0 + 8 && it < NITEMS; ++it) {
        long r = it;
#define CONV_LG(cnt, IDX, Kd, Nd, DST, DROWS, MAP, GK) if (r < 2L * (cnt)) { const int l = (int)(r / (cnt)); const int q = (int)(r % (cnt)); const int nblk = (Nd) / 32, kb = q / nblk, nb = q % nblk; \
            conv_item(INF(IDX) + (size_t)l * (Kd) * (Nd), (Nd), 64 * kb, 32 * nb, (bf16*)(ws + (DST)) + (size_t)l * (DROWS) * (Kd), (Kd), MAP, scr, lane, GK); continue; } r -= 2L * (cnt);
#define CONV_L(cnt, IDX, Kd, Nd, DST, DROWS, MAP) CONV_LG(cnt, IDX, Kd, Nd, DST, DROWS, MAP, nullptr)
        if (r < 2L * I_IN) { const int l = (int)(r / I_IN), q = (int)(r % I_IN), kb = q / 282, nb = q % 282, n0 = 32 * nb;
            if (n0 >= 832 && n0 < 1856) conv_item(INF(4) + (size_t)l * 2048 * INW, INW, 64 * kb, n0, (bf16*)(ws + WS_W_IN) + (size_t)l * ZNB * 2048, 2048, n0 - 832, scr, lane);
            else conv_item8(INF(4) + (size_t)l * 2048 * INW, INW, 64 * kb, n0, ws + WS_W_IN8 + (size_t)l * ZN8 * 2048, 2048, map_win8(n0), GATE_WSC, scr, lane);
            continue; } r -= 2L * I_IN;
        CONV_LG(I_UQ, 6, 512, 1536, WS_W_UQ, 1536, 32 * nb, INF(5) + l * 512)
        CONV_LG(I_UKV, 8, 256, 2048, WS_W_UKV, 2048, map_ukv(32 * nb), INF(7) + l * 256)
        CONV_L(I_MO, 11, 1024, 2048, WS_W_MLAOUT, 2048, 32 * nb)
        if (r < 2L * 4 * I_PW) { const int lg = (int)(r / I_PW), q = (int)(r % I_PW), kb = q / 8, nb = q % 8;
            conv_item(INF(12) + (size_t)lg * 65536, 256, 64 * kb, 32 * nb, (bf16*)(ws + WS_W_POOL), 256, lg * 256 + 32 * nb, scr, lane); continue; } r -= 2L * 4 * I_PW;
        CONV_L(I_MO, 14, 1024, 2048, WS_W_POOLOUT, 2048, 32 * nb)
        CONV_L(I_MKV, 16, 2048, 2048, WS_W_MEMKV, 2048, 32 * nb)
        CONV_L(I_MO, 19, 1024, 2048, WS_W_MEMOUT, 2048, 32 * nb)
        CONV_L(I_WO, 20, 2048, 2048, WS_W_O, 2048, 32 * nb)
#undef CONV_L
#undef CONV_LG
        if (r < 2L * I_DG) { const int up = (int)(r / I_DG), q = (int)(r % I_DG), kb = q / 176, nb = q % 176;
            conv_item(INF(22 + up), DFF, 64 * kb, 32 * nb, (bf16*)(ws + WS_W_DGU), 2048, map_gu(32 * nb, up), scr, lane); continue; } r -= 2L * I_DG;
        if (r < I_DD) { const int q = (int)r, kb = q / 64, nb = q % 64;
            conv_item(INF(24), 2048, 64 * kb, 32 * nb, (bf16*)(ws + WS_W_DD), DFF, 32 * nb, scr, lane); continue; } r -= I_DD;
        if (r < 16L * I_MG) { const int eu = (int)(r / I_MG), e = eu >> 1, up = eu & 1, q = (int)(r % I_MG), kb = q / 224, nb = q % 224;
            conv_item8(INF(27 + up) + (size_t)e * 2048 * DFE, DFE, 64 * kb, 32 * nb, ws + WS_W_MGU + (size_t)e * 14336 * 2048, 2048, map_gu(32 * nb, up), MOE_WSC_UP, scr, lane); continue; } r -= 16L * I_MG;
        { const int e = (int)(r / I_MDN), q = (int)(r % I_MDN), kb = q / 64, nb = q % 64;
            conv_item8(INF(29) + (size_t)e * DFE * 2048, 2048, 64 * kb, 32 * nb, ws + WS_W_MD + (size_t)e * 2048 * DFE, DFE, 32 * nb, MOE_WSC_DN, scr, lane); }
      }
    }
    for (int i = gw; i < 2 * 192; i += NGW) { const int l = i / 192, rr = (ZC_KPE - ZC_CQ) + 64 + i % 192; u32x4* p = (u32x4*)(ws + WS_W_IN8 + ((size_t)l * ZN8 + rr) * 2048);
#pragma unroll
        for (int j = 0; j < 2; ++j) p[lane + 64 * j] = (u32x4){0u, 0u, 0u, 0u}; }
    float* ct = (float*)(ws + WS_ROPE); float* st = ct + (size_t)T * 32;
    const int* pos = (const int*)ld_tbl(lds, 2);
    for (int i = gw * 64 + lane; i < T * 32; i += NGW * 64) { const int t = i >> 5, f = i & 31;
        const float inv_freq = powf(10000.0f, -(float)(2 * f) / 64.0f);
        const float ang = (float)pos[t] * inv_freq;
        const double rev = (double)ang * 0.15915494309189535; const float fr = (float)(rev - rint(rev));
        ct[i] = __builtin_amdgcn_cosf(fr); st[i] = __builtin_amdgcn_sinf(fr); }
}

__device__ __forceinline__ void norm_row_2048(const float* xrow, const float* g, bf16* orow, unsigned char* orow8, int lane) {
    f32x4 v[8]; float s = 0.f;
#pragma unroll
    for (int j = 0; j < 8; ++j) { v[j] = ((const f32x4*)xrow)[lane + 64 * j]; s += (v[j][0] * v[j][0] + v[j][1] * v[j][1]) + (v[j][2] * v[j][2] + v[j][3] * v[j][3]); }
    const float rinv = 1.0f / sqrtf(wave_sum(s) * (1.0f / 2048.0f) + EPS);
#pragma unroll
    for (int j = 0; j < 8; ++j) { const f32x4 gv = ((const f32x4*)g)[lane + 64 * j]; const f32x4 o = v[j] * rinv * gv;
        u32x2 w; w.x = cvt_pk_bf16(o[0], o[1]); w.y = cvt_pk_bf16(o[2], o[3]); ((u32x2*)orow)[lane + 64 * j] = w;
        if (orow8) { int w8 = 0; w8 = __builtin_amdgcn_cvt_pk_fp8_f32(o[0], o[1], w8, false); w8 = __builtin_amdgcn_cvt_pk_fp8_f32(o[2], o[3], w8, true); ((unsigned*)orow8)[lane + 64 * j] = (unsigned)w8; } }
}
__device__ __forceinline__ void p_norm(const float* y, const float* g, bf16* H, unsigned char* H8, const float* mem, const float* gm, bf16* MEMN, int gw, int NGW, int lane) {
    for (int m = gw; m < T; m += NGW) norm_row_2048(y + (size_t)m * DM, g, H + (size_t)m * DM, H8 ? H8 + (size_t)m * DM : nullptr, lane);
    if (mem) for (int m = gw; m < MROWS; m += NGW) norm_row_2048(mem + (size_t)m * DM, gm, MEMN + (size_t)m * DM, nullptr, lane);
}
__device__ __forceinline__ void p_postz(const bf16* Z, float* RS, float* RQ, bf16* POOLED, int gw, int NGW, int lane) {
    for (int t = gw; t < T; t += NGW) {
        const bf16* zr = Z + (size_t)t * ZW;
        {
            const u32x2 w = *(const u32x2*)(zr + ZC_CKV + 4 * lane);
            const float x0 = bf_lo(w.x), x1 = bf_hi(w.x), x2 = bf_lo(w.y), x3 = bf_hi(w.y);
            const float ss = wave_sum(x0 * x0 + x1 * x1 + x2 * x2 + x3 * x3);
            if (lane == 0) RS[t] = 1.0f / sqrtf(ss * (1.0f / 256.0f) + EPS);
        }
        {
            const u32x4 w0 = *(const u32x4*)(zr + ZC_QM + 16 * lane), w1 = *(const u32x4*)(zr + ZC_QM + 16 * lane + 8);
            const float x[16] = {bf_lo(w0.x), bf_hi(w0.x), bf_lo(w0.y), bf_hi(w0.y), bf_lo(w0.z), bf_hi(w0.z), bf_lo(w0.w), bf_hi(w0.w),
                                 bf_lo(w1.x), bf_hi(w1.x), bf_lo(w1.y), bf_hi(w1.y), bf_lo(w1.z), bf_hi(w1.z), bf_lo(w1.w), bf_hi(w1.w)};
            float ss = 0.f;
#pragma unroll
            for (int j = 0; j < 16; ++j) ss += x[j] * x[j];
            ss += __shfl_xor(ss, 1); ss += __shfl_xor(ss, 2); ss += __shfl_xor(ss, 4); ss += __shfl_xor(ss, 8);
            if ((lane & 15) == 0) RQ[4 * t + (lane >> 4)] = (1.0f / sqrtf(ss * (1.0f / 256.0f) + EPS)) * (0.0625f * LOG2E);
        }
        {
            const int s = t & (SEQ - 1), grp = lane >> 4, w = 2 << grp, n = (s + 1) < w ? (s + 1) : w;
            u32x4 ra[16], rb[16];
#pragma unroll
            for (int d = 0; d < 16; ++d) { ra[d] = (u32x4){0u, 0u, 0u, 0u}; rb[d] = (u32x4){0u, 0u, 0u, 0u};
                if (d < n) { const bf16* ur = zr - (size_t)d * ZW + ZC_POOL + 16 * lane; ra[d] = *(const u32x4*)ur; rb[d] = *(const u32x4*)(ur + 8); } }
            float acc[16], own[16];
#pragma unroll
            for (int j = 0; j < 16; ++j) acc[j] = 0.f;
#pragma unroll
            for (int d = 0; d < 16; ++d) { const u32x4 w0 = ra[d], w1 = rb[d];
                const float x[16] = {bf_lo(w0.x), bf_hi(w0.x), bf_lo(w0.y), bf_hi(w0.y), bf_lo(w0.z), bf_hi(w0.z), bf_lo(w0.w), bf_hi(w0.w),
                                     bf_lo(w1.x), bf_hi(w1.x), bf_lo(w1.y), bf_hi(w1.y), bf_lo(w1.z), bf_hi(w1.z), bf_lo(w1.w), bf_hi(w1.w)};
#pragma unroll
                for (int j = 0; j < 16; ++j) { acc[j] += x[j]; if (d == 0) own[j] = x[j]; } }
            const float rn = 1.0f / (float)n; unsigned o[8];
#pragma unroll
            for (int j = 0; j < 8; ++j) o[j] = cvt_pk_bf16(acc[2 * j] * rn - own[2 * j], acc[2 * j + 1] * rn - own[2 * j + 1]);
            bf16* pr = POOLED + (size_t)t * 1024 + 16 * lane;
            *(u32x4*)pr = (u32x4){o[0], o[1], o[2], o[3]}; *(u32x4*)(pr + 8) = (u32x4){o[4], o[5], o[6], o[7]};
        }
    }
}
__device__ __forceinline__ void p_postqkv(bf16* QB, const bf16* KNOPE, const bf16* Z, bf16* KB, bf16* KM, const float* gq, const float* gk, const float* gkm, const float* gqm,
                                          const float* ct, const float* st, int gw, int NGW, int lane) {
    const int h = lane >> 3, j8 = lane & 7;
    for (int t = gw; t < T; t += NGW) {
        const f32x4 cs = *(const f32x4*)(ct + (size_t)t * 32 + 4 * j8), sn = *(const f32x4*)(st + (size_t)t * 32 + 4 * j8);
        {
            bf16* qr = QB + (size_t)t * 1536 + h * 192;
            const u32x4 w0 = *(const u32x4*)(qr + 16 * j8), w1 = *(const u32x4*)(qr + 16 * j8 + 8);
            const u32x2 r1 = *(const u32x2*)(qr + 128 + 4 * j8), r2 = *(const u32x2*)(qr + 160 + 4 * j8);
            float x[16] = {bf_lo(w0.x), bf_hi(w0.x), bf_lo(w0.y), bf_hi(w0.y), bf_lo(w0.z), bf_hi(w0.z), bf_lo(w0.w), bf_hi(w0.w),
                           bf_lo(w1.x), bf_hi(w1.x), bf_lo(w1.y), bf_hi(w1.y), bf_lo(w1.z), bf_hi(w1.z), bf_lo(w1.w), bf_hi(w1.w)};
            float a[4] = {bf_lo(r1.x), bf_hi(r1.x), bf_lo(r1.y), bf_hi(r1.y)}, b[4] = {bf_lo(r2.x), bf_hi(r2.x), bf_lo(r2.y), bf_hi(r2.y)};
            float s = 0.f;
#pragma unroll
            for (int j = 0; j < 16; ++j) s += x[j] * x[j];
#pragma unroll
            for (int j = 0; j < 4; ++j) s += a[j] * a[j] + b[j] * b[j];
            s += __shfl_xor(s, 1); s += __shfl_xor(s, 2); s += __shfl_xor(s, 4);
            const float rinv = (1.0f / sqrtf(s * (1.0f / 192.0f) + EPS)) * (0.07216878364870322f * LOG2E);
            unsigned o[8];
#pragma unroll
            for (int j = 0; j < 8; ++j) o[j] = cvt_pk_bf16(x[2 * j] * rinv * gq[16 * j8 + 2 * j], x[2 * j + 1] * rinv * gq[16 * j8 + 2 * j + 1]);
            *(u32x4*)(qr + 16 * j8) = (u32x4){o[0], o[1], o[2], o[3]}; *(u32x4*)(qr + 16 * j8 + 8) = (u32x4){o[4], o[5], o[6], o[7]};
            float y1[4], y2[4];
#pragma unroll
            for (int j = 0; j < 4; ++j) { const float x1 = a[j] * rinv * gq[128 + 4 * j8 + j], x2 = b[j] * rinv * gq[160 + 4 * j8 + j]; y1[j] = x1 * cs[j] - x2 * sn[j]; y2[j] = x2 * cs[j] + x1 * sn[j]; }
            *(u32x2*)(qr + 128 + 4 * j8) = (u32x2){cvt_pk_bf16(y1[0], y1[1]), cvt_pk_bf16(y1[2], y1[3])};
            *(u32x2*)(qr + 160 + 4 * j8) = (u32x2){cvt_pk_bf16(y2[0], y2[1]), cvt_pk_bf16(y2[2], y2[3])};
        }
        {
            const bf16* kn = KNOPE + (size_t)t * 1024 + h * 128 + 16 * j8; const bf16* kp = Z + (size_t)t * ZW + ZC_KPE;
            const u32x4 w0 = *(const u32x4*)kn, w1 = *(const u32x4*)(kn + 8);
            const u32x2 r1 = *(const u32x2*)(kp + 4 * j8), r2 = *(const u32x2*)(kp + 32 + 4 * j8);
            float x[16] = {bf_lo(w0.x), bf_hi(w0.x), bf_lo(w0.y), bf_hi(w0.y), bf_lo(w0.z), bf_hi(w0.z), bf_lo(w0.w), bf_hi(w0.w),
                           bf_lo(w1.x), bf_hi(w1.x), bf_lo(w1.y), bf_hi(w1.y), bf_lo(w1.z), bf_hi(w1.z), bf_lo(w1.w), bf_hi(w1.w)};
            float a[4] = {bf_lo(r1.x), bf_hi(r1.x), bf_lo(r1.y), bf_hi(r1.y)}, b[4] = {bf_lo(r2.x), bf_hi(r2.x), bf_lo(r2.y), bf_hi(r2.y)};
            float s = 0.f;
#pragma unroll
            for (int j = 0; j < 16; ++j) s += x[j] * x[j];
#pragma unroll
            for (int j = 0; j < 4; ++j) s += a[j] * a[j] + b[j] * b[j];
            s += __shfl_xor(s, 1); s += __shfl_xor(s, 2); s += __shfl_xor(s, 4);
            const float rinv = 1.0f / sqrtf(s * (1.0f / 192.0f) + EPS);
            bf16* kr = KB + (size_t)t * 1536 + h * 192;
            unsigned o[8];
#pragma unroll
            for (int j = 0; j < 8; ++j) o[j] = cvt_pk_bf16(x[2 * j] * rinv * gk[16 * j8 + 2 * j], x[2 * j + 1] * rinv * gk[16 * j8 + 2 * j + 1]);
            *(u32x4*)(kr + 16 * j8) = (u32x4){o[0], o[1], o[2], o[3]}; *(u32x4*)(kr + 16 * j8 + 8) = (u32x4){o[4], o[5], o[6], o[7]};
            float y1[4], y2[4];
#pragma unroll
            for (int j = 0; j < 4; ++j) { const float x1 = a[j] * rinv * gk[128 + 4 * j8 + j], x2 = b[j] * rinv * gk[160 + 4 * j8 + j]; y1[j] = x1 * cs[j] - x2 * sn[j]; y2[j] = x2 * cs[j] + x1 * sn[j]; }
            *(u32x2*)(kr + 128 + 4 * j8) = (u32x2){cvt_pk_bf16(y1[0], y1[1]), cvt_pk_bf16(y1[2], y1[3])};
            *(u32x2*)(kr + 160 + 4 * j8) = (u32x2){cvt_pk_bf16(y2[0], y2[1]), cvt_pk_bf16(y2[2], y2[3])};
        }
    }
    for (int m = gw; m < MROWS; m += NGW) {
        bf16* kr = KM + (size_t)m * 1024 + 16 * lane;
        const u32x4 w0 = *(const u32x4*)kr, w1 = *(const u32x4*)(kr + 8);
        float x[16] = {bf_lo(w0.x), bf_hi(w0.x), bf_lo(w0.y), bf_hi(w0.y), bf_lo(w0.z), bf_hi(w0.z), bf_lo(w0.w), bf_hi(w0.w),
                       bf_lo(w1.x), bf_hi(w1.x), bf_lo(w1.y), bf_hi(w1.y), bf_lo(w1.z), bf_hi(w1.z), bf_lo(w1.w), bf_hi(w1.w)};
        float s = 0.f;
#pragma unroll
        for (int j = 0; j < 16; ++j) s += x[j] * x[j];
        s += __shfl_xor(s, 1); s += __shfl_xor(s, 2); s += __shfl_xor(s, 4); s += __shfl_xor(s, 8);
        const float rinv = 1.0f / sqrtf(s * (1.0f / 256.0f) + EPS);
        const float* gp = gkm + 16 * (lane & 15); const float* gq2 = gqm + 16 * (lane & 15);
        unsigned o[8];
#pragma unroll
        for (int j = 0; j < 8; ++j) o[j] = cvt_pk_bf16(x[2 * j] * rinv * gp[2 * j] * gq2[2 * j], x[2 * j + 1] * rinv * gp[2 * j + 1] * gq2[2 * j + 1]);
        *(u32x4*)kr = (u32x4){o[0], o[1], o[2], o[3]}; *(u32x4*)(kr + 8) = (u32x4){o[4], o[5], o[6], o[7]};
    }
}

template <int DQK, bool CAUSAL, bool STAG>
__device__ __forceinline__ void attn_unit(LAS unsigned char* lds, const bf16* Qp, int qpitch, const bf16* Kp, int kpitch, const bf16* Vtp, int vpitch,
                                          bf16* Op, int opitch, int q0, int ntiles, const float* rowscale = nullptr, int rs_stride = 0) {
    constexpr int NS = DQK / 16, KRS = DQK * 2 + 16, KTB = 64 * KRS, VRS = 136, VTB = 128 * VRS, KPR = DQK / 8, NKP = 64 * KPR / 512;
    const int tid = launder_i(threadIdx.x), wid = __builtin_amdgcn_readfirstlane(tid >> 6), lane = tid & 63, c = lane & 31, hi = lane >> 5;
    bf16x8 qr[NS];
    { const bf16* qrow = Qp + (size_t)(32 * wid + c) * qpitch + 8 * hi;
#pragma unroll
      for (int s = 0; s < NS; ++s) qr[s] = *(const bf16x8*)(qrow + 16 * s); }
    u32x4 kst[NKP], vst[2];
    int krow[NKP], kcc[NKP];
#pragma unroll
    for (int i = 0; i < NKP; ++i) { const int p = tid + 512 * i; krow[i] = p / KPR; kcc[i] = p % KPR; }
    const int vrow0 = tid >> 3, vcc = tid & 7;
#define AT_ISSUE(j) do { _Pragma("unroll") for (int i = 0; i < NKP; ++i) kst[i] = *(const u32x4*)(Kp + (size_t)(64 * (j) + krow[i]) * kpitch + kcc[i] * 8); \
        _Pragma("unroll") for (int i = 0; i < 2; ++i) vst[i] = *(const u32x4*)(Vtp + (size_t)(vrow0 + 64 * i) * vpitch + 64 * (j) + vcc * 8); } while (0)
#define AT_WRITE(b) do { _Pragma("unroll") for (int i = 0; i < NKP; ++i) *(LAS u32x4*)(lds + (b) * KTB + krow[i] * KRS + kcc[i] * 16) = kst[i]; \
        _Pragma("unroll") for (int i = 0; i < 2; ++i) { LAS unsigned char* vp = lds + 2 * KTB + (b) * VTB + (vrow0 + 64 * i) * VRS + vcc * 16; \
            *(LAS u32x2*)vp = (u32x2){vst[i].x, vst[i].y}; *(LAS u32x2*)(vp + 8) = (u32x2){vst[i].z, vst[i].w}; } } while (0)
    f32x16 o[4];
#pragma unroll
    for (int d = 0; d < 4; ++d)
#pragma unroll
        for (int r = 0; r < 16; ++r) o[d][r] = 0.f;
    float m_run = -1e30f, l_run = 0.f;
    const int qpos = q0 + 32 * wid + c;
    const float rsc = rowscale ? rowscale[(size_t)(32 * wid + c) * rs_stride] : 1.0f;
    const bool grpB = STAG && wid >= 4;
    bf16x8 pf[4];
#pragma unroll
    for (int i = 0; i < 4; ++i) pf[i] = (bf16x8){0, 0, 0, 0, 0, 0, 0, 0};
#define AT_PV(vbuf) do { const LAS unsigned char* vb = lds + 2 * KTB + (vbuf) * VTB + c * VRS + hi * 8; \
        _Pragma("unroll") for (int d = 0; d < 4; ++d) _Pragma("unroll") for (int ks = 0; ks < 4; ++ks) { \
            const u32x2 lo = *(const LAS u32x2*)(vb + d * 32 * VRS + ks * 32), h8 = *(const LAS u32x2*)(vb + d * 32 * VRS + ks * 32 + 16); \
            const u32x4 av = {lo.x, lo.y, h8.x, h8.y}; \
            o[d] = __builtin_amdgcn_mfma_f32_32x32x16_bf16(__builtin_bit_cast(bf16x8, av), pf[ks], o[d], 0, 0, 0); } } while (0)
#define AT_ACTIVE(j) (!CAUSAL || (64 * (j) <= q0 + 32 * wid + 31))
    AT_ISSUE(0);
#pragma unroll
    for (int i = 0; i < NKP; ++i) *(LAS u32x4*)(lds + krow[i] * KRS + kcc[i] * 16) = kst[i];
#pragma unroll
    for (int i = 0; i < 2; ++i) { LAS unsigned char* vp = lds + 2 * KTB + (vrow0 + 64 * i) * VRS + vcc * 16; *(LAS u32x2*)vp = (u32x2){vst[i].x, vst[i].y}; *(LAS u32x2*)(vp + 8) = (u32x2){vst[i].z, vst[i].w}; }
    __syncthreads();
    int vcur = 0;
    for (int j = 0; j < ntiles; ++j) {
        const int b = j & 1, vprev = vcur == 0 ? 2 : vcur - 1, vnext = vcur == 2 ? 0 : vcur + 1;
        if (j + 1 < ntiles) AT_ISSUE(j + 1);
        if (grpB && j > 0 && AT_ACTIVE(j - 1)) AT_PV(vprev);
        if (AT_ACTIVE(j)) {
            f32x16 p0, p1;
#pragma unroll
            for (int r = 0; r < 16; ++r) { p0[r] = 0.f; p1[r] = 0.f; }
            const LAS unsigned char* kb = lds + b * KTB + c * KRS + hi * 16;
#pragma unroll
            for (int s = 0; s < NS; ++s) {
                const bf16x8 a0 = *(const LAS bf16x8*)(kb + 32 * s), a1 = *(const LAS bf16x8*)(kb + 32 * KRS + 32 * s);
                p0 = __builtin_amdgcn_mfma_f32_32x32x16_bf16(a0, qr[s], p0, 0, 0, 0);
                p1 = __builtin_amdgcn_mfma_f32_32x32x16_bf16(a1, qr[s], p1, 0, 0, 0);
                if (DQK > 192 && (s & 3) == 3) __builtin_amdgcn_sched_barrier(0);
            }
            if (rowscale) {
#pragma unroll
                for (int r = 0; r < 16; ++r) { p0[r] *= rsc; p1[r] *= rsc; } }
            if (CAUSAL && (64 * j + 63 > q0 + 32 * wid)) {
                const float NEG = -__builtin_inff();
#pragma unroll
                for (int r = 0; r < 16; ++r) { const int key = 64 * j + (r & 3) + 8 * (r >> 2) + 4 * hi;
                    if (key > qpos) p0[r] = NEG; if (key + 32 > qpos) p1[r] = NEG; }
            }
            float mx = p0[0];
#pragma unroll
            for (int r = 1; r < 16; ++r) mx = fmaxf(mx, p0[r]);
#pragma unroll
            for (int r = 0; r < 16; ++r) mx = fmaxf(mx, p1[r]);
            mx = fmaxf(mx, __shfl_xor(mx, 32));
            const float mnew = fmaxf(m_run, mx), alpha = __builtin_amdgcn_exp2f(m_run - mnew);
            m_run = mnew;
            float ps = 0.f;
#pragma unroll
            for (int r = 0; r < 16; ++r) { p0[r] = __builtin_amdgcn_exp2f(p0[r] - mnew); p1[r] = __builtin_amdgcn_exp2f(p1[r] - mnew); ps += p0[r] + p1[r]; }
            l_run = l_run * alpha + ps;
            if (__any(alpha != 1.0f)) {
#pragma unroll
                for (int d = 0; d < 4; ++d)
#pragma unroll
                    for (int r = 0; r < 16; ++r) o[d][r] *= alpha;
            }
#pragma unroll
            for (int s = 0; s < 2; ++s) {
                u32x4 w0 = {cvt_pk_bf16(p0[8 * s + 0], p0[8 * s + 1]), cvt_pk_bf16(p0[8 * s + 2], p0[8 * s + 3]), cvt_pk_bf16(p0[8 * s + 4], p0[8 * s + 5]), cvt_pk_bf16(p0[8 * s + 6], p0[8 * s + 7])};
                u32x4 w1 = {cvt_pk_bf16(p1[8 * s + 0], p1[8 * s + 1]), cvt_pk_bf16(p1[8 * s + 2], p1[8 * s + 3]), cvt_pk_bf16(p1[8 * s + 4], p1[8 * s + 5]), cvt_pk_bf16(p1[8 * s + 6], p1[8 * s + 7])};
                pf[s] = __builtin_bit_cast(bf16x8, w0); pf[2 + s] = __builtin_bit_cast(bf16x8, w1);
            }
            if (!grpB) AT_PV(vcur);
        }
        if (j + 1 < ntiles) {
#pragma unroll
            for (int i = 0; i < NKP; ++i) *(LAS u32x4*)(lds + (b ^ 1) * KTB + krow[i] * KRS + kcc[i] * 16) = kst[i];
#pragma unroll
            for (int i = 0; i < 2; ++i) { LAS unsigned char* vp = lds + 2 * KTB + vnext * VTB + (vrow0 + 64 * i) * VRS + vcc * 16; *(LAS u32x2*)vp = (u32x2){vst[i].x, vst[i].y}; *(LAS u32x2*)(vp + 8) = (u32x2){vst[i].z, vst[i].w}; }
        }
        __syncthreads();
        vcur = vnext;
    }
    if (grpB && AT_ACTIVE(ntiles - 1)) { const int vlast = vcur == 0 ? 2 : vcur - 1; AT_PV(vlast); }
#undef AT_PV
#undef AT_ACTIVE
    const float lt = l_run + __shfl_xor(l_run, 32), inv = 1.0f / lt;
    bf16* orow = Op + (size_t)(32 * wid + c) * opitch + 4 * hi;
#pragma unroll
    for (int d = 0; d < 4; ++d)
#pragma unroll
        for (int g = 0; g < 4; ++g) {
            u32x2 w; w.x = cvt_pk_bf16(o[d][4 * g + 0] * inv, o[d][4 * g + 1] * inv); w.y = cvt_pk_bf16(o[d][4 * g + 2] * inv, o[d][4 * g + 3] * inv);
            *(u32x2*)(orow + 32 * d + 8 * g) = w;
        }
    __syncthreads();
#undef AT_ISSUE
#undef AT_WRITE
}
__device__ __forceinline__ void p_attention(LAS unsigned char* lds, unsigned char* ws, int G, int bid) {
    const bf16* QB = (const bf16*)(ws + WS_QB); const bf16* KB = (const bf16*)(ws + WS_KB); const bf16* VT = (const bf16*)(ws + WS_VT); bf16* OMLA = (bf16*)(ws + WS_OMLA);
    const bf16* Z = (const bf16*)(ws + WS_Z); const bf16* KM = (const bf16*)(ws + WS_KM); const bf16* VMT = (const bf16*)(ws + WS_VMT); bf16* OMEM = (bf16*)(ws + WS_OMEM);
#ifndef ATT_SKIP_MLA
    for (int it = bid; it < 256; it += G) {
        const int bh = it >> 2, p = it & 3, b = bh >> 3, h = bh & 7;
#pragma unroll 1
        for (int pass = 0; pass < 2; ++pass) {
            const int qb = pass ? 7 - p : p, q0 = qb * 256;
            attn_unit<192, true, true>(lds, QB + ((size_t)(b * SEQ + q0)) * 1536 + h * 192, 1536, KB + (size_t)(b * SEQ) * 1536 + h * 192, 1536,
                                 VT + (size_t)(h * 128) * T + b * SEQ, T, OMLA + (size_t)(b * SEQ + q0) * 1024 + h * 128, 1024, q0, (q0 + 256) / 64);
        }
    }
#endif
#ifndef ATT_SKIP_MEM
    for (int it = bid; it < 512; it += G) {
        const int dh = it & 1, qb = (it >> 1) & 7, h = (it >> 4) & 3, b = it >> 6, q0 = qb * 256;
        attn_unit<256, false, false>(lds, Z + (size_t)(b * SEQ + q0) * ZW + ZC_QM + h * 256, ZW, KM + (size_t)(b * MEMT) * 1024 + h * 256, 1024,
                              VMT + (size_t)(h * 256 + dh * 128) * MROWS + b * MEMT, MROWS, OMEM + (size_t)(b * SEQ + q0) * 1024 + h * 256 + dh * 128, 1024, q0, 4, (const float*)(ws + WS_MOE + MO_RQ) + (size_t)(b * SEQ + q0) * 4 + h, 4);
    }
#endif
}

__device__ __forceinline__ void p_ffnnorm_router(LAS unsigned char* lds, const float* y, const float* g, bf16* H, const float* rw, const float* rb,
                                                 int* toke, float* tokw, int* hist, int G, int bid, int tid, int wave, int lane) {
    LAS float* rwl = (LAS float*)lds;
    LAS int* ce = (LAS int*)(lds + 65536);
    for (int idx = tid; idx < 2048 * 8; idx += 512) { const int k = idx >> 3, e = idx & 7; rwl[e * 2048 + k] = rw[idx]; }
    __syncthreads();
    for (int c = bid; c < 256; c += G) {
        for (int i = 0; i < 8; ++i) {
            const int tl = 8 * wave + i, t = 64 * c + tl;
            const float* xrow = y + (size_t)t * DM;
            f32x4 v[8]; float s = 0.f;
#pragma unroll
            for (int j = 0; j < 8; ++j) { v[j] = ((const f32x4*)xrow)[lane + 64 * j]; s += (v[j][0] * v[j][0] + v[j][1] * v[j][1]) + (v[j][2] * v[j][2] + v[j][3] * v[j][3]); }
            const float rinv = 1.0f / sqrtf(wave_sum(s) * (1.0f / 2048.0f) + EPS);
            bf16* orow = H + (size_t)t * DM;
#pragma unroll
            for (int j = 0; j < 8; ++j) { const f32x4 gv = ((const f32x4*)g)[lane + 64 * j]; v[j] = v[j] * rinv * gv;
                u32x2 w; w.x = cvt_pk_bf16(v[j][0], v[j][1]); w.y = cvt_pk_bf16(v[j][2], v[j][3]); ((u32x2*)orow)[lane + 64 * j] = w; }
            float lg[8];
#pragma unroll
            for (int e = 0; e < 8; ++e) { float a = 0.f;
#pragma unroll
                for (int j = 0; j < 8; ++j) { const f32x4 w = *(const LAS f32x4*)(rwl + e * 2048 + 4 * (lane + 64 * j)); a += (v[j][0] * w[0] + v[j][1] * w[1]) + (v[j][2] * w[2] + v[j][3] * w[3]); }
                lg[e] = wave_sum(a) + rb[e]; }
            int e0 = 0; float l0 = lg[0];
#pragma unroll
            for (int e = 1; e < 8; ++e) if (lg[e] > l0) { l0 = lg[e]; e0 = e; }
            int e1 = -1; float l1 = -3.0e38f;
#pragma unroll
            for (int e = 0; e < 8; ++e) if (e != e0 && lg[e] > l1) { l1 = lg[e]; e1 = e; }
            const float g1 = 1.0f / (1.0f + expf(l0 - l1)), g0 = 1.0f - g1;
            if (lane == 0) { toke[2 * t] = e0; toke[2 * t + 1] = e1; tokw[2 * t] = g0; tokw[2 * t + 1] = g1; ce[2 * tl] = e0; ce[2 * tl + 1] = e1; }
        }
        __syncthreads();
        if (wave == 0) { const int e0 = ce[2 * lane], e1 = ce[2 * lane + 1]; int mine = 0;
#pragma unroll
            for (int e = 0; e < 8; ++e) { const int cnt = __popcll(__ballot(e0 == e)) + __popcll(__ballot(e1 == e)); if (lane == e) mine = cnt; }
            if (lane < 8) hist[c * 8 + lane] = mine; }
        __syncthreads();
    }
}
__device__ __forceinline__ void p_moe_assign(LAS unsigned char* lds, const bf16* H, const int* toke, const int* hist, int* toks, int* tilee, unsigned char* XG,
                                             int G, int bid, int tid, int wave, int lane) {
    LAS int* hl = (LAS int*)lds;
    LAS int* ps = (LAS int*)(lds + 8192);
    LAS int* cs = (LAS int*)(lds + 8192 + 64);
    for (int i = tid; i < 2048; i += 512) hl[i] = ld_agent_i(hist + i);
    __syncthreads();
    if (tid < 8) { int run = 0; for (int c = 0; c < 256; ++c) { const int v = hl[c * 8 + tid]; hl[c * 8 + tid] = run; run += v; } ps[8 + tid] = (run + 255) & ~255; }
    __syncthreads();
    if (tid == 0) { int p = 0; for (int e = 0; e < 8; ++e) { ps[e] = p; p += ps[8 + e]; }
        if (bid == 0) { int nt = 0; for (int e = 0; e < 8; ++e) { const int n = ps[8 + e] >> 8; for (int i = 0; i < n; ++i) tilee[nt + i] = e; nt += n; } tilee[MAXTILES] = nt; } }
    __syncthreads();
    for (int c = bid; c < 256; c += G) {
        if (wave == 0) { const int t = 64 * c + lane; const int e0 = toke[2 * t], e1 = toke[2 * t + 1]; int s0 = 0, s1 = 0;
            const unsigned long long lt = (1ull << lane) - 1ull;
#pragma unroll
            for (int e = 0; e < 8; ++e) { const unsigned long long b0 = __ballot(e0 == e), b1 = __ballot(e1 == e);
                const int below = __popcll(b0 & lt) + __popcll(b1 & lt), base = ps[e] + hl[c * 8 + e] + below;
                if (e0 == e) s0 = base; if (e1 == e) s1 = base; }
            toks[2 * t] = s0; toks[2 * t + 1] = s1; cs[2 * lane] = s0; cs[2 * lane + 1] = s1; }
        __syncthreads();
        for (int i = 0; i < 16; ++i) { const int a = 16 * wave + i, tl = a >> 1, slot = cs[a];
            const u32x4* src = (const u32x4*)(H + (size_t)(64 * c + tl) * DM); u32x2* dst = (u32x2*)(XG + (size_t)slot * DM);
#pragma unroll
            for (int j = 0; j < 4; ++j) { const u32x4 w = src[lane + 64 * j]; int w0 = 0, w1 = 0;
                w0 = __builtin_amdgcn_cvt_pk_fp8_f32(bf_lo(w.x), bf_hi(w.x), w0, false); w0 = __builtin_amdgcn_cvt_pk_fp8_f32(bf_lo(w.y), bf_hi(w.y), w0, true);
                w1 = __builtin_amdgcn_cvt_pk_fp8_f32(bf_lo(w.z), bf_hi(w.z), w1, false); w1 = __builtin_amdgcn_cvt_pk_fp8_f32(bf_lo(w.w), bf_hi(w.w), w1, true);
                dst[lane + 64 * j] = (u32x2){(unsigned)w0, (unsigned)w1}; } }
        __syncthreads();
    }
}
__device__ __forceinline__ void p_moe_combine(float* y, const bf16* YS, const int* toks, const float* tokw, int gw, int NGW, int lane) {
    for (int t = gw; t < T; t += NGW) {
        const int s0 = toks[2 * t], s1 = toks[2 * t + 1]; const float w0 = tokw[2 * t], w1 = tokw[2 * t + 1];
        f32x4* yr = (f32x4*)(y + (size_t)t * DM); const u32x2* a = (const u32x2*)(YS + (size_t)s0 * DM); const u32x2* b = (const u32x2*)(YS + (size_t)s1 * DM);
#pragma unroll
        for (int j = 0; j < 8; ++j) { f32x4 v = yr[lane + 64 * j]; const u32x2 x = a[lane + 64 * j], z = b[lane + 64 * j];
            v[0] += w0 * bf_lo(x.x) + w1 * bf_lo(z.x); v[1] += w0 * bf_hi(x.x) + w1 * bf_hi(z.x); v[2] += w0 * bf_lo(x.y) + w1 * bf_lo(z.y); v[3] += w0 * bf_hi(x.y) + w1 * bf_hi(z.y);
            yr[lane + 64 * j] = v; }
    }
}

constexpr int NPH_L = 13;
constexpr int NPHASES = 1 + NLAYER * NPH_L;
#ifndef PHMASK
#define PHMASK 0xFFFFFFFu
#endif
#define PHON(p) ((PHMASK >> (p)) & 1u)
#ifndef DUPMASK
#define DUPMASK 0u
#endif
#define NREP(p) (1 + (int)((DUPMASK >> (p)) & 1u))
#ifndef P3MASK
#define P3MASK 0x3Fu
#endif
#define P3ON(i) ((P3MASK >> (i)) & 1u)
#define WSP(T_, OFF) ((T_*)(ws + (OFF)))
#define IN(k) (lo <= (k) && (k) < hi)
#define SEAM(k) do { if ((k) + 1 < hi) { XcdBarrier b2; b2.bar = (unsigned*)ld_tbl(lds, 31) + CW_BAR; b2.x = xb_xcc_id(); b2.st = (volatile LAS unsigned*)(lds + MISC_OFF) + 8; xcd_barrier(b2); } } while (0)
#define PH_PRE() const int tid = launder_i(threadIdx.x), lane = tid & 63, wave = __builtin_amdgcn_readfirstlane(tid >> 6); \
                 const int vcu = (G % 8 == 0) ? (bid % 8) * (G / 8) + bid / 8 : bid; const int gw = vcu * 8 + wave, NGW = G * 8; \
                 unsigned char* ws = (unsigned char*)ld_tbl(lds, 31); (void)tid; (void)lane; (void)gw; (void)NGW; (void)ws
typedef pg8::Sched Sched;
template <int l> __device__ __forceinline__ void run_layer(LAS unsigned char* lds, const int lo, const int hi, const int G, const int bid) {
        const int P = 1 + l * NPH_L;
        if (l > 0 && PHON(0) && IN(P + 0)) { PH_PRE(); const float* ybase = (l == 0) ? INF(0) : INF(30);
            p_norm(ybase, INF(3) + l * DM, WSP(bf16, WS_H), WSP(unsigned char, WS_H8), INF(1), INF(15) + l * DM, WSP(bf16, WS_MEMN), gw, NGW, lane); SEAM(P + 0); }
        if (PHON(1) && IN(P + 1)) {
#pragma unroll 1
          for (int rep = 0; rep < NREP(1); ++rep) {
            { PH_PRE(); const bf16* W = WSP(const bf16, WS_W_IN) + (size_t)l * ZNB * DM;
              Sched S = pg8::make_sched(WSP(const bf16, WS_H), DM, W, DM, T / 256, ZNB / 256, G, bid);
              pg8::EpiBf16<0> E{WSP(bf16, WS_Z), ZW, 0, 0, nullptr, 1.f};
              pg8::gemm_phase<pg8::EpiBf16<0>, true>(lds, DM, DM, DM, S, E); }
            { PH_PRE(); const bf16* W8 = (const bf16*)(ws + WS_W_IN8 + (size_t)l * ZN8 * 2048);
              Sched S = pg8::make_sched(WSP(const bf16, WS_H8), DM / 2, W8, DM / 2, T / 256, ZN8 / 256, G, bid);
              pg8::EpiBf16<1> E{WSP(bf16, WS_Z) + ZC_CQ, ZW, (ZC_GATE - ZC_CQ) / 256, 1 << 30, nullptr, 1.0f / GATE_WSC};
              pg8::gemm_phase<pg8::EpiBf16<1>, true, true>(lds, DM / 2, DM / 2, DM / 2, S, E); }
          }
            SEAM(P + 1);
        }
        if (PHON(2) && IN(P + 2)) { PH_PRE(); p_postz(WSP(const bf16, WS_Z), WSP(float, WS_MOE + MO_RS), WSP(float, WS_MOE + MO_RQ), WSP(bf16, WS_POOLED), gw, NGW, lane); SEAM(P + 2); }
        if (PHON(3) && IN(P + 3)) {
#pragma unroll 1
          for (int rep = 0; rep < NREP(3); ++rep) {
            if (P3ON(0)) { PH_PRE(); const bf16* W = WSP(const bf16, WS_W_UQ) + (size_t)l * 1536 * 512;
              Sched S = pg8::make_sched(WSP(const bf16, WS_Z) + ZC_CQ, ZW, W, 512, T / 256, 6, (G * 3) / 4, bid < (G * 3) / 4 ? bid : (1 << 29));
              pg8::EpiBf16<0> E{WSP(bf16, WS_QB), 1536, 0, 0, nullptr, 1.f}; pg8::gemm_phase<pg8::EpiBf16<0>, true>(lds, 512, ZW, 512, S, E); }
            if (P3ON(1)) { PH_PRE(); const bf16* W = WSP(const bf16, WS_W_UKV) + (size_t)l * 2048 * 256;
              Sched S = pg8::make_sched(WSP(const bf16, WS_Z) + ZC_CKV, ZW, W, 256, T / 256, 4, G, (bid + 128) % G);
              pg8::EpiBf16<4> E{WSP(bf16, WS_KNOPE), 1024, 0, 0, WSP(const float, WS_MOE + MO_RS), 1.f}; pg8::gemm_phase<pg8::EpiBf16<4>, true>(lds, 256, ZW, 256, S, E); }
            if (P3ON(2)) { PH_PRE(); const bf16* W = WSP(const bf16, WS_W_UKV) + (size_t)l * 2048 * 256 + (size_t)1024 * 256;
              Sched S = pg8::make_sched(W, 256, WSP(const bf16, WS_Z) + ZC_CKV, ZW, 4, T / 256, G, bid);
              pg8::EpiBf16<2> E{WSP(bf16, WS_VT), T, 0, 0, WSP(const float, WS_MOE + MO_RS), 1.f}; pg8::gemm_phase<pg8::EpiBf16<2>, true>(lds, 256, 256, ZW, S, E); }
            if (P3ON(3)) { PH_PRE(); const bf16* W = WSP(const bf16, WS_W_POOL) + (size_t)l * 1024 * 256;
              Sched S = pg8::make_sched(WSP(const bf16, WS_POOLED), 1024, W, 256, T / 256, 4, G, bid); S.a_pn = 256 * 2;
              pg8::EpiBf16<2> E{WSP(bf16, WS_MIXED), 1024, 0, 0, INF(13) + l * 1024, 1.f}; pg8::gemm_phase<pg8::EpiBf16<2>, true>(lds, 256, 1024, 256, S, E); }
            if (P3ON(4)) { PH_PRE(); const bf16* W = WSP(const bf16, WS_W_MEMKV) + (size_t)l * 2048 * 2048;
              Sched S = pg8::make_sched(WSP(const bf16, WS_MEMN), DM, W, DM, MROWS / 256, 4, G, (bid + G / 4) % G);
              pg8::EpiBf16<0> E{WSP(bf16, WS_KM), 1024, 0, 0, nullptr, 1.f}; pg8::gemm_phase<pg8::EpiBf16<0>, true>(lds, DM, DM, DM, S, E); }
            if (P3ON(5)) { PH_PRE(); const bf16* W = WSP(const bf16, WS_W_MEMKV) + (size_t)l * 2048 * 2048 + (size_t)1024 * 2048;
              Sched S = pg8::make_sched(W, DM, WSP(const bf16, WS_MEMN), DM, 4, MROWS / 256, G, (bid + G / 8) % G);
              pg8::EpiBf16<0> E{WSP(bf16, WS_VMT), MROWS, 0, 0, nullptr, 1.f}; pg8::gemm_phase<pg8::EpiBf16<0>, true>(lds, DM, DM, DM, S, E); }
          }
            SEAM(P + 3);
        }
        if (PHON(4) && IN(P + 4)) { PH_PRE(); const float* ct = WSP(const float, WS_ROPE);
            p_postqkv(WSP(bf16, WS_QB), WSP(const bf16, WS_KNOPE), WSP(const bf16, WS_Z), WSP(bf16, WS_KB), WSP(bf16, WS_KM), INF(9) + l * 192, INF(10) + l * 192, INF(18) + l * 256, INF(17) + l * 256,
                      ct, ct + (size_t)T * 32, gw, NGW, lane); SEAM(P + 4); }
        if (PHON(5) && IN(P + 5)) { PH_PRE(); p_attention(lds, ws, G, bid);
#ifdef DUP_ATT
            __syncthreads(); p_attention(lds, ws, G, bid);
#endif
            SEAM(P + 5); }
        if (PHON(6) && IN(P + 6)) { PH_PRE();
            pg8::SchedChain3 S; S.so.init(T / 256, 8, G, bid); S.a_tile = (size_t)256 * 1024 * 2; S.b_tile = (size_t)256 * 1024 * 2; S.a_sub = 32 * MiB; S.b_sub = 8 * MiB;
            S.A = (const char*)WSP(const bf16, WS_MIXED); S.B = (const char*)(WSP(const bf16, WS_W_POOLOUT) + (size_t)l * 2048 * 1024);
            static_assert(WS_OMLA == WS_MIXED + 32 * MiB && WS_OMEM == WS_MIXED + 64 * MiB && WS_W_MLAOUT == WS_W_POOLOUT + 8 * MiB && WS_W_MEMOUT == WS_W_POOLOUT + 16 * MiB, "chain strides");
            pg8::EpiChain3 E{WSP(const bf16, WS_Z) + ZC_GATE, ZW, 2048, WSP(bf16, WS_MERGED), DM};
#pragma unroll 1
            for (int rep = 0; rep < NREP(6); ++rep) pg8::gemm_phase<pg8::EpiChain3, true, false, pg8::SchedChain3>(lds, 1024, 1024, 1024, S, E);
            SEAM(P + 6);
        }
        if (PHON(7) && IN(P + 7)) { PH_PRE(); const float* ybase = (l == 0) ? INF(0) : INF(30);
            const bf16* W = WSP(const bf16, WS_W_O) + (size_t)l * 2048 * 2048; Sched S = pg8::make_sched(WSP(const bf16, WS_MERGED), DM, W, DM, T / 256, 8, G, bid);
            pg8::EpiResid E{ybase, (float*)INF(30), DM}; pg8::gemm_phase<pg8::EpiResid, true>(lds, DM, DM, DM, S, E);
            SEAM(P + 7);
        }
        if (PHON(8) && IN(P + 8)) { PH_PRE();
            if (l == 0) p_norm(INF(30), INF(21) + l * DM, WSP(bf16, WS_H), nullptr, nullptr, nullptr, nullptr, gw, NGW, lane);
            else p_ffnnorm_router(lds, INF(30), INF(21) + l * DM, WSP(bf16, WS_H), INF(25), INF(26), WSP(int, WS_MOE + MO_TOKE), WSP(float, WS_MOE + MO_TOKW), WSP(int, WS_MOE + MO_HIST), G, bid, tid, wave, lane);
            SEAM(P + 8);
        }
        if (l == 0) {
            if (PHON(9) && IN(P + 9)) { PH_PRE(); Sched S = pg8::make_sched(WSP(const bf16, WS_H), DM, WSP(const bf16, WS_W_DGU), DM, T / 256, 2 * DFF / 256, G, bid);
                pg8::EpiSwiGLU E{WSP(bf16, WS_G), DFF};
#pragma unroll 1
                for (int rep = 0; rep < NREP(9); ++rep) pg8::gemm_phase<pg8::EpiSwiGLU, true>(lds, DM, DM, DM, S, E); SEAM(P + 9); }
            if (PHON(10) && IN(P + 10)) { PH_PRE(); Sched S = pg8::make_sched(WSP(const bf16, WS_G), DFF, WSP(const bf16, WS_W_DD), DFF, T / 256, 8, G, bid);
                pg8::EpiResid E{INF(30), (float*)INF(30), DM}; pg8::gemm_phase<pg8::EpiResid, true>(lds, DFF, DFF, DFF, S, E); SEAM(P + 10); }
        } else {
            if (PHON(9) && IN(P + 9)) { PH_PRE(); p_moe_assign(lds, WSP(const bf16, WS_H), WSP(const int, WS_MOE + MO_TOKE), WSP(const int, WS_MOE + MO_HIST), WSP(int, WS_MOE + MO_TOKS), WSP(int, WS_MOE + MO_TILEE), WSP(unsigned char, WS_XG), G, bid, tid, wave, lane); SEAM(P + 9); }
            if (PHON(10) && IN(P + 10)) { PH_PRE(); const int* tilee_g = WSP(const int, WS_MOE + MO_TILEE); const int ntl = __builtin_amdgcn_readfirstlane(ld_agent_i(tilee_g + MAXTILES));
                LAS int* tilee = (LAS int*)(lds + TILEE_OFF); if (tid < MAXTILES) tilee[tid] = ld_agent_i(tilee_g + tid); __syncthreads();
                Sched S = pg8::make_sched(WSP(const bf16, WS_XG), DM / 2, WSP(const bf16, WS_W_MGU), DM / 2, ntl, 2 * DFE / 256, G, bid); S.tile_e = tilee; S.b_exp = (size_t)14336 * 2048;
                pg8::EpiSwiGLU8 E{WSP(unsigned char, WS_GM), DFE, 1.0f / MOE_WSC_UP, MOE_GSC};
#pragma unroll 1
                for (int rep = 0; rep < NREP(10); ++rep) pg8::gemm_phase<pg8::EpiSwiGLU8, true, true>(lds, DM / 2, DM / 2, DM / 2, S, E); SEAM(P + 10); }
            if (PHON(11) && IN(P + 11)) { PH_PRE(); const int* tilee_g = WSP(const int, WS_MOE + MO_TILEE); const int ntl = __builtin_amdgcn_readfirstlane(ld_agent_i(tilee_g + MAXTILES));
                LAS int* tilee = (LAS int*)(lds + TILEE_OFF); if (tid < MAXTILES) tilee[tid] = ld_agent_i(tilee_g + tid); __syncthreads();
                Sched S = pg8::make_sched(WSP(const bf16, WS_GM), DFE / 2, WSP(const bf16, WS_W_MD), DFE / 2, ntl, 8, G, bid); S.tile_e = tilee; S.b_exp = (size_t)2048 * DFE;
                pg8::EpiBf16<3> E{WSP(bf16, WS_YS), DM, 0, 0, nullptr, 1.0f / (MOE_GSC * MOE_WSC_DN)};
#pragma unroll 1
                for (int rep = 0; rep < NREP(11); ++rep) pg8::gemm_phase<pg8::EpiBf16<3>, true, true>(lds, DFE / 2, DFE / 2, DFE / 2, S, E); SEAM(P + 11); }
            if (PHON(12) && IN(P + 12)) { PH_PRE(); p_moe_combine((float*)INF(30), WSP(const bf16, WS_YS), WSP(const int, WS_MOE + MO_TOKS), WSP(const float, WS_MOE + MO_TOKW), gw, NGW, lane); }
        }
}
__global__ void __launch_bounds__(512, 2) mega_fwd(Args args) {
    extern __shared__ __attribute__((aligned(16))) unsigned char lds_raw[];
    LAS unsigned char* lds = (LAS unsigned char*)lds_raw;
    volatile LAS unsigned* MISC = (volatile LAS unsigned*)(lds + MISC_OFF);
    const int tid0 = threadIdx.x;
    for (int u = tid0; u < (LDS_BYTES - LDSCTL_OFF) / 4; u += 512) ((LAS unsigned*)(lds + LDSCTL_OFF))[u] = 0u;
    __syncthreads();
    if (tid0 == 0) { LAS unsigned long long* tb = (LAS unsigned long long*)(lds + TBL_OFF);
#pragma unroll
        for (int i = 0; i < 30; ++i) tb[i] = (unsigned long long)args.in[i];
        tb[30] = (unsigned long long)args.out; tb[31] = (unsigned long long)args.ws; }
    const int lo = args.ph_lo, hi = args.ph_hi;
    __syncthreads();
    const int G = gridDim.x, bid = blockIdx.x;
    if (!MK_PER_PHASE) (void)xcd_barrier_post((unsigned*)ld_tbl(lds, 31) + CW_BAR, MISC + 8);
    if (PHON(20) && IN(0)) { PH_PRE(); p_prologue(lds, gw, NGW, wave, lane);
#ifdef DUP_PRO
        __syncthreads(); p_prologue(lds, gw, NGW, wave, lane);
#endif
        p_norm(INF(0), INF(3), WSP(bf16, WS_H), WSP(unsigned char, WS_H8), INF(1), INF(15), WSP(bf16, WS_MEMN), gw, NGW, lane);
        SEAM(0); }
    run_layer<0>(lds, lo, hi, G, bid);
    run_layer<1>(lds, lo, hi, G, bid);
}
#undef IN
#undef SEAM


extern "C" void kernel_launch(void* const* d_in, const int* in_sizes, int n_in, void* d_out, int out_size, void* d_ws, size_t ws_size, hipStream_t stream) {
    static int grid = 0;
    if (grid == 0) {
        if (n_in != 30 || out_size != T * DM || ws_size < WS_END) { fprintf(stderr, "kernel_launch: unexpected shapes (n_in %d out %d ws %zu, need ws >= %zu)\n", n_in, out_size, ws_size, (size_t)WS_END); grid = -1; return; }
        int dev = 0, cus = 0, per_cu = 0;
        if (hipGetDevice(&dev) != hipSuccess || hipDeviceGetAttribute(&cus, hipDeviceAttributeMultiprocessorCount, dev) != hipSuccess) { grid = -1; return; }
        if (hipFuncSetAttribute((const void*)mega_fwd, hipFuncAttributeMaxDynamicSharedMemorySize, LDS_BYTES) != hipSuccess) { fprintf(stderr, "kernel_launch: hipFuncSetAttribute failed\n"); grid = -1; return; }
        if (hipOccupancyMaxActiveBlocksPerMultiprocessor(&per_cu, (const void*)mega_fwd, 512, LDS_BYTES) != hipSuccess || per_cu < 1) fprintf(stderr, "kernel_launch: occupancy query says %d\n", per_cu);
        (void)hipGetLastError();
        grid = cus;
    }
    if (grid < 0) return;
    (void)hipMemsetAsync((char*)d_ws + WS_CTL, 0, CTL_ZERO_BYTES, stream);
    Args a{};
    for (int i = 0; i < 30; ++i) a.in[i] = d_in[i];
    a.out = (float*)d_out; a.ws = (unsigned char*)d_ws;
#if MK_PER_PHASE
    for (int k = 0; k < NPHASES; ++k) { a.ph_lo = k; a.ph_hi = k + 1; hipLaunchKernelGGL(mega_fwd, dim3(grid), dim3(512), LDS_BYTES, stream, a); }
#else
    a.ph_lo = 0; a.ph_hi = NPHASES;
    hipLaunchKernelGGL(mega_fwd, dim3(grid), dim3(512), LDS_BYTES, stream, a);
#endif
}
```

```cpp
#include <hip/hip_runtime.h>
#include <cstdio>
#include <cstdint>

#define LAS __attribute__((address_space(3)))
#define GAS __attribute__((address_space(1)))
typedef unsigned short bf16;
typedef short bf16x8 __attribute__((ext_vector_type(8)));
typedef float f32x4 __attribute__((ext_vector_type(4)));
typedef float f32x2 __attribute__((ext_vector_type(2)));
typedef float f32x16 __attribute__((ext_vector_type(16)));
typedef unsigned u32x4 __attribute__((ext_vector_type(4)));
typedef unsigned u32x2 __attribute__((ext_vector_type(2)));

#ifndef MK_PER_PHASE
#define MK_PER_PHASE 0
#endif

constexpr int T = 16384, DM = 2048, NB = 8, SEQ = 2048, NLAYER = 2;
constexpr int MEMT = 256, MROWS = NB * MEMT;
constexpr int ZW = 9216;
constexpr int ZC_POOL = 0, ZC_CQ = 1024, ZC_CKV = 1536, ZC_QM = 1792, ZC_KPE = 2816, ZC_GATE = 3072;
constexpr int ZNB = 1024, ZN8 = 8192;
constexpr float GATE_WSC = 128.f;
constexpr int INW = 9024;
constexpr int DFF = 5632, DFE = 7168, NEXP = 8;
constexpr int MAXTILES = 136, MAXSLOTS = MAXTILES * 256;
constexpr float EPS = 1e-6f;
constexpr float LOG2E = 1.4426950408889634f;
constexpr float MOE_WSC_UP = 128.f, MOE_WSC_DN = 256.f, MOE_GSC = 8.f;

constexpr size_t MiB = 1u << 20;
constexpr size_t WS_CTL = 0, CTL_ZERO_BYTES = 1 * MiB;
constexpr size_t WS_ROPE = 2 * MiB;
constexpr size_t WS_MOE = 6 * MiB;
constexpr size_t WS_W_IN = 8 * MiB;
constexpr size_t WS_W_IN8 = 32 * MiB;
constexpr size_t WS_H8 = 544 * MiB;
constexpr size_t WS_W_UQ = 80 * MiB;
constexpr size_t WS_W_UKV = 83 * MiB;
constexpr size_t WS_W_POOLOUT = 85 * MiB;
constexpr size_t WS_W_MLAOUT = 93 * MiB;
constexpr size_t WS_W_MEMOUT = 101 * MiB;
constexpr size_t WS_W_POOL = 109 * MiB;
constexpr size_t WS_W_MEMKV = 110 * MiB;
constexpr size_t WS_W_O = 126 * MiB;
constexpr size_t WS_W_DGU = 142 * MiB;
constexpr size_t WS_W_DD = 186 * MiB;
constexpr size_t WS_W_MGU = 208 * MiB;
constexpr size_t WS_W_MD = 432 * MiB;
constexpr size_t WS_H = 880 * MiB;
constexpr size_t WS_MEMN = 944 * MiB;
constexpr size_t WS_KM = 952 * MiB;
constexpr size_t WS_VMT = 956 * MiB;
constexpr size_t WS_R = 960 * MiB;
constexpr size_t WS_Z = WS_R;
constexpr size_t WS_QB = WS_R + 288 * MiB;
constexpr size_t WS_KNOPE = WS_R + 336 * MiB;
constexpr size_t WS_KB = WS_R + 368 * MiB;
constexpr size_t WS_VT = WS_R + 416 * MiB;
constexpr size_t WS_POOLED = WS_R + 448 * MiB;
constexpr size_t WS_MIXED = WS_R + 480 * MiB;
constexpr size_t WS_OMLA = WS_R + 512 * MiB;
constexpr size_t WS_OMEM = WS_R + 544 * MiB;
constexpr size_t WS_MACC = WS_R + 576 * MiB;
constexpr size_t WS_MERGED = WS_R + 704 * MiB;
constexpr size_t WS_G = WS_R;
constexpr size_t WS_XG = WS_R;
constexpr size_t WS_GM = WS_R + 68 * MiB;
constexpr size_t WS_YS = WS_R + 306 * MiB;
constexpr size_t WS_END = WS_R + 768 * MiB;
constexpr size_t MO_TOKE = 0;
constexpr size_t MO_TOKW = 128 * 1024;
constexpr size_t MO_TOKS = 256 * 1024;
constexpr size_t MO_HIST = 384 * 1024;
constexpr size_t MO_TILEE = 400 * 1024;
constexpr size_t MO_RS = 512 * 1024;
constexpr size_t MO_RQ = 1024 * 1024;
constexpr int CW_BAR = 4096;

constexpr int RING_BYTES = 131072;
constexpr int LDSCTL_OFF = RING_BYTES, MISC_OFF = LDSCTL_OFF + 320;
constexpr int LDS_BYTES = 147456;
constexpr int TILEE_OFF = LDSCTL_OFF + 2048;
constexpr int TBL_OFF = LDSCTL_OFF + 1024;

__device__ __forceinline__ unsigned cvt_pk_bf16(float lo, float hi) { unsigned r; asm volatile("v_cvt_pk_bf16_f32 %0, %1, %2" : "=v"(r) : "v"(lo), "v"(hi)); return r; }
__device__ __forceinline__ float bf_lo(unsigned w) { return __uint_as_float(w << 16); }
__device__ __forceinline__ float bf_hi(unsigned w) { return __uint_as_float(w & 0xffff0000u); }
__device__ __forceinline__ float wave_sum(float v) {
#pragma unroll
    for (int o = 1; o < 64; o <<= 1) v += __shfl_xor(v, o);
    return v;
}
__device__ __forceinline__ float fast_sigmoid(float x) { return __builtin_amdgcn_rcpf(1.0f + __builtin_amdgcn_exp2f(-x * LOG2E)); }
__device__ __forceinline__ int ld_agent_i(const int* p) { return (int)__hip_atomic_load((const unsigned*)p, __ATOMIC_RELAXED, __HIP_MEMORY_SCOPE_AGENT); }
__device__ __forceinline__ int launder_i(int x) { asm volatile("" : "+v"(x)); return x; }
__device__ __forceinline__ const void* ld_tbl(LAS unsigned char* lds, int i) { const LAS unsigned* t = (const LAS unsigned*)(lds + TBL_OFF) + 2 * i; const unsigned lo = __builtin_amdgcn_readfirstlane(t[0]), hi = __builtin_amdgcn_readfirstlane(t[1]);
    return (const void*)(GAS const void*)(((unsigned long long)hi << 32) | lo); }
#define INF(i) ((const float*)ld_tbl(lds, (i)))
#define LDS_WAIT() asm volatile("s_waitcnt lgkmcnt(0)" ::: "memory")
#define VM_WAIT() asm volatile("s_waitcnt vmcnt(0)" ::: "memory")

namespace pg8 {
constexpr int BM = 256, BK = 64, HALF = 128, HTB = HALF * BK * 2, STAGE_BYTES = 8 * HTB, NXCD = 8, WGM = 8;
__host__ __device__ __forceinline__ int lds_byte(int r, int c) { const int st = (r >> 4) * 2 + (c >> 5), rr = r & 15, cc = c & 31, ob = rr * 64 + cc * 2; return st * 1024 + (ob ^ (((ob >> 9) & 1) << 5)); }
__host__ __device__ __forceinline__ void stage_rc(int b, int& R, int& C) { const int st = b / 1024, sb = b % 1024, swz = sb ^ (((sb >> 9) & 1) << 5); R = (st >> 1) * 16 + swz / 64; C = (st & 1) * 32 + (swz % 64) / 2; }
__host__ __device__ __forceinline__ int perm32(int rho) { const int n = rho >> 4, i = rho & 15; return 8 * (i >> 2) + 4 * n + (i & 3); }

struct Unit { int pm, pn, sub; };
struct StaticOrder {
    int nM, nN, nwg, G, c;
    __device__ void init(int nM_, int nN_, int G_, int c_) { nM = nM_; nN = nN_; nwg = nM * nN; G = G_; c = c_; }
    __device__ bool next(int i, Unit& u) const {
        const long L = (long)i * G + c; if (L >= nwg) return false;
        int wgid = (int)L; { const int q = nwg / NXCD, r = nwg % NXCD, xcd = wgid % NXCD, off = wgid / NXCD; wgid = (xcd < r ? xcd * (q + 1) : r * (q + 1) + (xcd - r) * q) + off; }
        const int nig = WGM * nN, gid = wgid / nig, fm = gid * WGM, gsz = (nM - fm) < WGM ? (nM - fm) : WGM;
        u.pm = fm + ((wgid % nig) % gsz); u.pn = (wgid % nig) / gsz; u.sub = 0; return true;
    }
};
struct Sched {
    StaticOrder so;
    const char* A; const char* B;
    size_t a_tile, b_tile, a_pn, b_exp;
    const LAS int* tile_e;
    __device__ __forceinline__ bool next(int i, Unit& u) const { return so.next(i, u); }
    __device__ __forceinline__ void ptrs(const Unit& u, const char*& cA, const char*& cB) const {
        int e = 0; if (tile_e) e = __builtin_amdgcn_readfirstlane(tile_e[u.pm]);
        cA = A + (size_t)u.pm * a_tile + (size_t)u.pn * a_pn; cB = B + (size_t)e * b_exp + (size_t)u.pn * b_tile;
    }
};
__device__ __forceinline__ Sched make_sched(const bf16* A, int lda, const bf16* Bt, int ldb, int nM, int nN, int G, int c) {
    Sched s; s.so.init(nM, nN, G, c); s.A = (const char*)A; s.B = (const char*)Bt; s.a_tile = (size_t)256 * lda * 2; s.b_tile = (size_t)256 * ldb * 2; s.a_pn = 0; s.b_exp = 0; s.tile_e = nullptr; return s;
}

struct SchedChain3 {
    StaticOrder so;
    const char* A; const char* B;
    size_t a_tile, b_tile, a_sub, b_sub;
    __device__ __forceinline__ bool next(int i, Unit& u) const { const bool ok = so.next(i / 3, u); u.sub = i % 3; return ok; }
    __device__ __forceinline__ void ptrs(const Unit& u, const char*& cA, const char*& cB) const {
        cA = A + (size_t)u.sub * a_sub + (size_t)u.pm * a_tile; cB = B + (size_t)u.sub * b_sub + (size_t)u.pn * b_tile;
    }
};
typedef int i32x8 __attribute__((ext_vector_type(8)));
typedef int i32x4 __attribute__((ext_vector_type(4)));
__device__ __forceinline__ i32x8 cat8(bf16x8 a, bf16x8 b) { const i32x4 x = __builtin_bit_cast(i32x4, a), y = __builtin_bit_cast(i32x4, b); return (i32x8){x[0], x[1], x[2], x[3], y[0], y[1], y[2], y[3]}; }
__device__ __forceinline__ void mfma8(f32x4& acc, i32x8 a, i32x8 b, int sc) { asm volatile("v_mfma_scale_f32_16x16x128_f8f6f4 %0, %1, %2, %0, %3, %3 op_sel_hi:[0,0,0]" : "+v"(acc) : "v"(a), "v"(b), "v"(sc)); }
template <class Epi, bool ALIGN_EPI, bool FP8 = false, class Sch = Sched>
__device__ __forceinline__ void gemm_phase(LAS unsigned char* lds, const int K, const int lda, const int ldb, const Sch& S, const Epi& E) {
    const int tid = launder_i(threadIdx.x), wid = __builtin_amdgcn_readfirstlane(tid >> 6), lane = tid & 63, wr = wid >> 2, wc = wid & 3, fr = lane & 15, fq = lane >> 4;
    const int nt = K / BK;
    unsigned voffA[2], voffB[2];
#pragma unroll
    for (int i = 0; i < 2; ++i) { int R, C; stage_rc(tid * 16 + i * 8192, R, C); const int Rb = (R & ~31) + perm32(R & 31);
        voffA[i] = (unsigned)(R * lda + C) * 2u; voffB[i] = (unsigned)(Rb * ldb + C) * 2u; }
    const size_t kstep = (size_t)(BK * 2);
    const size_t hstepA = (size_t)HALF * lda * 2, hstepB = (size_t)HALF * ldb * 2;
    const unsigned ldsw = (unsigned)wid * 1024u;
    const int aoff = lds_byte(wr * 64 + fr, fq * 8), boff = lds_byte(wc * 32 + fr, fq * 8);
#define PG8_SA(b, h) (((b) * 2 + (h)) * HTB)
#define PG8_SB(b, h) ((4 + (b) * 2 + (h)) * HTB)
#define PG8_STAGE(bufoff, gbase, voff) do { _Pragma("unroll") for (int _i = 0; _i < 2; ++_i) \
        __builtin_amdgcn_global_load_lds((const unsigned*)((const char*)(gbase) + (voff)[_i]), (LAS unsigned*)(lds + (bufoff) + ldsw + _i * 8192), 16, 0, 0); } while (0)
#define PG8_LDA(dst, b, h) do { _Pragma("unroll") for (int m = 0; m < 4; ++m) _Pragma("unroll") for (int k = 0; k < 2; ++k) dst[m][k] = *(const LAS bf16x8*)(lds + PG8_SA(b, h) + aoff + m * 2048 + k * 1024); } while (0)
#define PG8_LDB(dst, b, h) do { _Pragma("unroll") for (int n = 0; n < 2; ++n) _Pragma("unroll") for (int k = 0; k < 2; ++k) dst[n][k] = *(const LAS bf16x8*)(lds + PG8_SB(b, h) + boff + n * 2048 + k * 1024); } while (0)
#define PG8_MMA(ai, bj, At, Bt) do { __builtin_amdgcn_s_setprio(1); _Pragma("unroll") for (int m = 0; m < 4; ++m) _Pragma("unroll") for (int n = 0; n < 2; ++n) { \
        if constexpr (FP8) mfma8(acc[ai][bj][m][n], cat8(Bt[n][0], Bt[n][1]), cat8(At[m][0], At[m][1]), one_scale); \
        else { _Pragma("unroll") for (int k = 0; k < 2; ++k) acc[ai][bj][m][n] = __builtin_amdgcn_mfma_f32_16x16x32_bf16(Bt[n][k], At[m][k], acc[ai][bj][m][n], 0, 0, 0); } } \
        __builtin_amdgcn_s_setprio(0); } while (0)
#define PG8_WAIT_V(n) asm volatile("s_waitcnt vmcnt(" #n ")" ::: "memory")
#define PG8_WAIT_L(n) asm volatile("s_waitcnt lgkmcnt(" #n ")" ::: "memory")
#define PG8_BAR __builtin_amdgcn_s_barrier()
#define PG8_SCHED __builtin_amdgcn_sched_barrier(0)
    Unit cur, nxt; int ui = 0;
    if (!S.next(0, cur)) return;
    f32x4 acc[2][2][4][2];
#pragma unroll
    for (int a = 0; a < 2; ++a)
#pragma unroll
        for (int b = 0; b < 2; ++b)
#pragma unroll
            for (int m = 0; m < 4; ++m)
#pragma unroll
                for (int n = 0; n < 2; ++n) acc[a][b][m][n] = (f32x4){0.f, 0.f, 0.f, 0.f};
    bf16x8 At[4][2], B0[2][2], B1[2][2];
    int one_scale = 0x7F7F7F7F; asm volatile("" : "+v"(one_scale));
    const char* cA; const char* cB; S.ptrs(cur, cA, cB);
    PG8_STAGE(PG8_SB(0, 0), cB, voffB); PG8_STAGE(PG8_SB(0, 1), cB + hstepB, voffB); PG8_STAGE(PG8_SA(0, 0), cA, voffA); PG8_STAGE(PG8_SA(0, 1), cA + hstepA, voffA);
    if (wr == 1) PG8_BAR;
    PG8_WAIT_V(2); PG8_BAR;
    PG8_STAGE(PG8_SB(1, 0), cB + kstep, voffB); PG8_STAGE(PG8_SA(1, 0), cA + kstep, voffA); PG8_STAGE(PG8_SB(1, 1), cB + hstepB + kstep, voffB);
    PG8_WAIT_V(6); PG8_BAR;
    for (;;) {
        const bool has_next = S.next(ui + 1, nxt);
        const char* nA = cA; const char* nB = cB; if (has_next) S.ptrs(nxt, nA, nB);
#pragma unroll 1
        for (int t = 0; t < nt; t += 2) {
            const bool last = (t == nt - 2);
            const char* a1 = cA + (size_t)(t + 1) * kstep;
            const char* a2 = last ? nA : cA + (size_t)(t + 2) * kstep; const char* b2 = last ? nB : cB + (size_t)(t + 2) * kstep;
            const char* a3 = a2 + kstep; const char* b3 = b2 + kstep;
            PG8_LDB(B0, 0, 0); PG8_LDB(B1, 0, 1); PG8_SCHED; PG8_LDA(At, 0, 0); PG8_STAGE(PG8_SA(1, 1), a1 + hstepA, voffA);
            PG8_WAIT_V(8); PG8_WAIT_L(0); PG8_BAR; PG8_MMA(0, 0, At, B0); PG8_MMA(0, 1, At, B1); PG8_BAR; PG8_SCHED;
            PG8_LDA(At, 0, 1); PG8_STAGE(PG8_SB(0, 0), b2, voffB); PG8_STAGE(PG8_SB(0, 1), b2 + hstepB, voffB); PG8_STAGE(PG8_SA(0, 0), a2, voffA);
            PG8_WAIT_V(8); PG8_WAIT_L(0); PG8_BAR; PG8_MMA(1, 0, At, B0); PG8_MMA(1, 1, At, B1); PG8_BAR; PG8_SCHED;
            PG8_LDB(B0, 1, 0); PG8_LDB(B1, 1, 1); PG8_SCHED; PG8_LDA(At, 1, 0); PG8_STAGE(PG8_SA(0, 1), a2 + hstepA, voffA);
            PG8_WAIT_V(8); PG8_WAIT_L(0); PG8_BAR; PG8_MMA(0, 0, At, B0); PG8_MMA(0, 1, At, B1); PG8_BAR; PG8_SCHED;
            PG8_LDA(At, 1, 1); PG8_STAGE(PG8_SB(1, 0), b3, voffB); PG8_STAGE(PG8_SB(1, 1), b3 + hstepB, voffB); PG8_STAGE(PG8_SA(1, 0), a3, voffA);
            PG8_WAIT_V(8); PG8_WAIT_L(0); PG8_BAR; PG8_MMA(1, 0, At, B0); PG8_MMA(1, 1, At, B1); PG8_BAR; PG8_SCHED;
        }
        if constexpr (ALIGN_EPI) { if (wr == 0) PG8_BAR; }
        if constexpr (FP8) asm volatile("s_nop 7\n\ts_nop 7" ::: "memory");
        E(acc, cur, wr, wc, fr, fq);
        if (!has_next) break;
        if (Epi::CHAIN == 0 || cur.sub == Epi::CHAIN - 1)
#pragma unroll
        for (int a = 0; a < 2; ++a)
#pragma unroll
            for (int b = 0; b < 2; ++b)
#pragma unroll
                for (int m = 0; m < 4; ++m)
#pragma unroll
                    for (int n = 0; n < 2; ++n) acc[a][b][m][n] = (f32x4){0.f, 0.f, 0.f, 0.f};
        cur = nxt; cA = nA; cB = nB; ++ui;
        if constexpr (ALIGN_EPI) { if (wr == 1) PG8_BAR; }
    }
    PG8_WAIT_V(0);
    if constexpr (!ALIGN_EPI) { if (wr == 0) PG8_BAR; }
    PG8_BAR;
#undef PG8_SA
#undef PG8_SB
#undef PG8_STAGE
#undef PG8_LDA
#undef PG8_LDB
#undef PG8_MMA
#undef PG8_WAIT_V
#undef PG8_WAIT_L
#undef PG8_BAR
#undef PG8_SCHED
}

template <int ACT> struct EpiBf16 {
    static constexpr int CHAIN = 0;
    bf16* O; int ldc; int act_lo, act_hi; const float* scale; float cmul;
    __device__ __forceinline__ void operator()(f32x4 (&acc)[2][2][4][2], const Unit& u, int wr, int wc, int fr, int fq) const {
        const int row0 = u.pm * BM + wr * 64 + fr, col0 = u.pn * BM + wc * 32 + 8 * fq;
        const bool sg = (ACT == 1) && u.pn >= act_lo && u.pn < act_hi;
        f32x4 sv[2][2];
        if (ACT == 2) {
#pragma unroll
            for (int bj = 0; bj < 2; ++bj)
#pragma unroll
                for (int n = 0; n < 2; ++n) sv[bj][n] = *(const f32x4*)(scale + col0 + bj * HALF + 4 * n);
        }
#pragma unroll
        for (int ai = 0; ai < 2; ++ai)
#pragma unroll
            for (int m = 0; m < 4; ++m) { bf16* rowp = O + (size_t)(row0 + ai * HALF + m * 16) * ldc + col0;
#pragma unroll
                for (int bj = 0; bj < 2; ++bj) { f32x4 v0 = acc[ai][bj][m][0], v1 = acc[ai][bj][m][1];
                    if (ACT == 1) { if (sg) {
#pragma unroll
                        for (int j = 0; j < 4; ++j) { v0[j] = fast_sigmoid(v0[j] * cmul); v1[j] = fast_sigmoid(v1[j] * cmul); } } else { v0 = v0 * cmul; v1 = v1 * cmul; } }
                    if (ACT == 2) { v0 = v0 * sv[bj][0]; v1 = v1 * sv[bj][1]; }
                    if (ACT == 3) { v0 = v0 * cmul; v1 = v1 * cmul; }
                    if (ACT == 4) { const float rsc = scale[row0 + ai * HALF + m * 16]; v0 = v0 * rsc; v1 = v1 * rsc; }
                    u32x4 w; w.x = cvt_pk_bf16(v0[0], v0[1]); w.y = cvt_pk_bf16(v0[2], v0[3]); w.z = cvt_pk_bf16(v1[0], v1[1]); w.w = cvt_pk_bf16(v1[2], v1[3]);
                    *(u32x4*)(rowp + bj * HALF) = w; } }
    }
};
template <int MODE> struct EpiGate {
    static constexpr int CHAIN = 0;
    const bf16* gate; int ldg; float* macc; bf16* out; int ldc;
    __device__ __forceinline__ void operator()(f32x4 (&acc)[2][2][4][2], const Unit& u, int wr, int wc, int fr, int fq) const {
        const int row0 = u.pm * BM + wr * 64 + fr, col0 = u.pn * BM + wc * 32 + 8 * fq;
#pragma unroll
        for (int ai = 0; ai < 2; ++ai)
#pragma unroll
            for (int m = 0; m < 4; ++m) { const size_t row = (size_t)(row0 + ai * HALF + m * 16);
#pragma unroll
                for (int bj = 0; bj < 2; ++bj) { const int col = col0 + bj * HALF;
                    const u32x4 g = *(const u32x4*)(gate + row * ldg + col);
                    f32x4 v0 = acc[ai][bj][m][0], v1 = acc[ai][bj][m][1];
                    v0[0] *= bf_lo(g.x); v0[1] *= bf_hi(g.x); v0[2] *= bf_lo(g.y); v0[3] *= bf_hi(g.y);
                    v1[0] *= bf_lo(g.z); v1[1] *= bf_hi(g.z); v1[2] *= bf_lo(g.w); v1[3] *= bf_hi(g.w);
                    float* mp = macc + row * ldc + col;
                    if (MODE >= 1) { v0 = v0 + *(const f32x4*)mp; v1 = v1 + *(const f32x4*)(mp + 4); }
                    if (MODE <= 1) { *(f32x4*)mp = v0; *(f32x4*)(mp + 4) = v1; }
                    else { u32x4 w; w.x = cvt_pk_bf16(v0[0], v0[1]); w.y = cvt_pk_bf16(v0[2], v0[3]); w.z = cvt_pk_bf16(v1[0], v1[1]); w.w = cvt_pk_bf16(v1[2], v1[3]);
                        *(u32x4*)(out + row * ldc + col) = w; } } }
    }
};
struct EpiChain3 {
    static constexpr int CHAIN = 3;
    const bf16* gate; int ldg; int gstride; bf16* out; int ldc;
    __device__ __forceinline__ void operator()(f32x4 (&acc)[2][2][4][2], const Unit& u, int wr, int wc, int fr, int fq) const {
        const int row0 = u.pm * BM + wr * 64 + fr, col0 = u.pn * BM + wc * 32 + 8 * fq;
#pragma unroll
        for (int ai = 0; ai < 2; ++ai)
#pragma unroll
            for (int m = 0; m < 4; ++m) { const size_t row = (size_t)(row0 + ai * HALF + m * 16);
#pragma unroll
                for (int bj = 0; bj < 2; ++bj) { const int col = col0 + bj * HALF;
                    const bf16* gp = gate + row * ldg + (size_t)u.sub * gstride + col;
                    const u32x4 g = *(const u32x4*)gp; const u32x4 h = *(const u32x4*)(gp + (u.sub < 2 ? gstride : 0));
                    f32x4 fa = {bf_lo(g.x), bf_hi(g.x), bf_lo(g.y), bf_hi(g.y)}, fb = {bf_lo(g.z), bf_hi(g.z), bf_lo(g.w), bf_hi(g.w)};
                    f32x4 da = {bf_lo(h.x), bf_hi(h.x), bf_lo(h.y), bf_hi(h.y)}, db = {bf_lo(h.z), bf_hi(h.z), bf_lo(h.w), bf_hi(h.w)};
#pragma unroll
                    for (int j = 0; j < 4; ++j) { fa[j] = fmaxf(fa[j], 1e-20f); fb[j] = fmaxf(fb[j], 1e-20f);
                        const float ra = __builtin_amdgcn_rcpf(fmaxf(da[j], 1e-20f)), rb = __builtin_amdgcn_rcpf(fmaxf(db[j], 1e-20f));
                        fa[j] = (u.sub < 2) ? fa[j] * ra : fa[j]; fb[j] = (u.sub < 2) ? fb[j] * rb : fb[j]; }
                    f32x4 v0 = acc[ai][bj][m][0], v1 = acc[ai][bj][m][1];
                    v0 = v0 * fa; v1 = v1 * fb;
                    if (u.sub < 2) { acc[ai][bj][m][0] = v0; acc[ai][bj][m][1] = v1; }
                    else { u32x4 w; w.x = cvt_pk_bf16(v0[0], v0[1]); w.y = cvt_pk_bf16(v0[2], v0[3]); w.z = cvt_pk_bf16(v1[0], v1[1]); w.w = cvt_pk_bf16(v1[2], v1[3]);
                        *(u32x4*)(out + row * ldc + col) = w; } } }
    }
};
struct EpiResid {
    static constexpr int CHAIN = 0;
    const float* base; float* out; int ldc;
    __device__ __forceinline__ void operator()(f32x4 (&acc)[2][2][4][2], const Unit& u, int wr, int wc, int fr, int fq) const {
        const int row0 = u.pm * BM + wr * 64 + fr, col0 = u.pn * BM + wc * 32 + 8 * fq;
#pragma unroll
        for (int ai = 0; ai < 2; ++ai)
#pragma unroll
            for (int m = 0; m < 4; ++m) { const size_t off = (size_t)(row0 + ai * HALF + m * 16) * ldc + col0;
#pragma unroll
                for (int bj = 0; bj < 2; ++bj) { const float* bp = base + off + bj * HALF; float* op = out + off + bj * HALF;
                    const f32x4 b0 = *(const f32x4*)bp, b1 = *(const f32x4*)(bp + 4);
                    *(f32x4*)op = b0 + acc[ai][bj][m][0]; *(f32x4*)(op + 4) = b1 + acc[ai][bj][m][1]; } }
    }
};
struct EpiSwiGLU {
    static constexpr int CHAIN = 0;
    bf16* O; int ldc;
    __device__ __forceinline__ void operator()(f32x4 (&acc)[2][2][4][2], const Unit& u, int wr, int wc, int fr, int fq) const {
        const int row0 = u.pm * BM + wr * 64 + fr, col0 = u.pn * HALF + wc * 32 + 8 * fq;
#pragma unroll
        for (int ai = 0; ai < 2; ++ai)
#pragma unroll
            for (int m = 0; m < 4; ++m) { bf16* rowp = O + (size_t)(row0 + ai * HALF + m * 16) * ldc + col0;
                f32x4 r[2];
#pragma unroll
                for (int n = 0; n < 2; ++n) { const f32x4 g = acc[ai][0][m][n], up = acc[ai][1][m][n];
#pragma unroll
                    for (int j = 0; j < 4; ++j) r[n][j] = g[j] * fast_sigmoid(g[j]) * up[j]; }
                u32x4 w; w.x = cvt_pk_bf16(r[0][0], r[0][1]); w.y = cvt_pk_bf16(r[0][2], r[0][3]); w.z = cvt_pk_bf16(r[1][0], r[1][1]); w.w = cvt_pk_bf16(r[1][2], r[1][3]);
                *(u32x4*)rowp = w; }
    }
};
struct EpiSwiGLU8 {
    static constexpr int CHAIN = 0;
    unsigned char* O; int ldc; float imul, omul;
    __device__ __forceinline__ void operator()(f32x4 (&acc)[2][2][4][2], const Unit& u, int wr, int wc, int fr, int fq) const {
        const int row0 = u.pm * BM + wr * 64 + fr, col0 = u.pn * HALF + wc * 32 + 8 * fq;
#pragma unroll
        for (int ai = 0; ai < 2; ++ai)
#pragma unroll
            for (int m = 0; m < 4; ++m) { unsigned char* rowp = O + (size_t)(row0 + ai * HALF + m * 16) * ldc + col0;
                float r[8];
#pragma unroll
                for (int n = 0; n < 2; ++n) { const f32x4 g = acc[ai][0][m][n] * imul, up = acc[ai][1][m][n] * (imul * omul);
#pragma unroll
                    for (int j = 0; j < 4; ++j) r[4 * n + j] = __builtin_amdgcn_fmed3f(g[j] * fast_sigmoid(g[j]) * up[j], -440.f, 440.f); }
                int w0 = 0, w1 = 0;
                w0 = __builtin_amdgcn_cvt_pk_fp8_f32(r[0], r[1], w0, false); w0 = __builtin_amdgcn_cvt_pk_fp8_f32(r[2], r[3], w0, true);
                w1 = __builtin_amdgcn_cvt_pk_fp8_f32(r[4], r[5], w1, false); w1 = __builtin_amdgcn_cvt_pk_fp8_f32(r[6], r[7], w1, true);
                *(u32x2*)rowp = (u32x2){(unsigned)w0, (unsigned)w1}; }
    }
};
}


constexpr long MOE_I_MG = 32L * 224, MOE_I_MDN = 112L * 64, MOE_NITEMS = 8L * (2 * MOE_I_MG + MOE_I_MDN);
constexpr int MOE_TK = 1, CW_TICKET_MOE = 8192;
__device__ __forceinline__ void conv_item8(const float* W, int ldw, int k0, int n0, unsigned char* WT, int Kb, int drow, float sc, LAS float* scr, int lane);
__device__ __forceinline__ int map_gu(int n0, int up);
__device__ __forceinline__ void moe_conv_one(LAS unsigned char* lds, long r, LAS float* scr, int lane) {
    unsigned char* ws = (unsigned char*)ld_tbl(lds, 31);
    if (r < 16L * MOE_I_MG) { const int eu = (int)(r / MOE_I_MG), e = eu >> 1, up = eu & 1, q = (int)(r % MOE_I_MG), kb = q / 224, nb = q % 224;
        conv_item8(INF(27 + up) + (size_t)e * 2048 * DFE, DFE, 64 * kb, 32 * nb, ws + WS_W_MGU + (size_t)e * 14336 * 2048, 2048, map_gu(32 * nb, up), MOE_WSC_UP, scr, lane); return; }
    r -= 16L * MOE_I_MG;
    { const int e = (int)(r / MOE_I_MDN), q = (int)(r % MOE_I_MDN), kb = q / 64, nb = q % 64;
        conv_item8(INF(29) + (size_t)e * DFE * 2048, 2048, 64 * kb, 32 * nb, ws + WS_W_MD + (size_t)e * 2048 * DFE, DFE, 32 * nb, MOE_WSC_DN, scr, lane); }
}
__device__ __forceinline__ unsigned bg_xcc_id() { return (unsigned)__builtin_amdgcn_s_getreg((3 << 11) | 20) & 7u; }
__device__ __forceinline__ bool moe_bg_ticket(LAS unsigned char* lds, int wave, int lane, unsigned q) {
    constexpr long PER_Q = MOE_NITEMS / 8;
    unsigned* ticket = (unsigned*)ld_tbl(lds, 31) + CW_TICKET_MOE + 64 * q;
    unsigned tk = 0; if (lane == 0) tk = __hip_atomic_fetch_add(ticket, 1u, __ATOMIC_RELAXED, __HIP_MEMORY_SCOPE_AGENT);
    const long i0 = (long)MOE_TK * (long)__builtin_amdgcn_readfirstlane((int)tk);
    if (i0 >= PER_Q) return false;
    LAS float* scr = (LAS float*)(lds + wave * 16384);
    for (long i = i0; i < i0 + MOE_TK && i < PER_Q; ++i) moe_conv_one(lds, (long)q * PER_Q + i, scr, lane);
    return true;
}
__device__ __forceinline__ void moe_bg_drain(LAS unsigned char* lds, int wave, int lane) {
    const unsigned q0 = bg_xcc_id();
    for (unsigned v = 0; v < 8; ++v) { const unsigned q = (q0 + v) & 7u; while (moe_bg_ticket(lds, wave, lane, q)) { } }
}

#define XB_TMO      128
#define XB_XCNT(j)  (256  + 64 * (j))
#define XB_XSUB(j)  (1280 + 64 * (j))
#define XB_XGEN(j)  (2304 + 64 * (j))
#define XB_TOP      3328
#define XB_TOPGEN   3392
#define XCD_BAR_WORDS 3456
#define XB_SPIN_CAP (1u << 20)
__device__ __forceinline__ unsigned xb_ld(unsigned* p)              { return __hip_atomic_load(p, __ATOMIC_RELAXED, __HIP_MEMORY_SCOPE_AGENT); }
__device__ __forceinline__ unsigned xb_add(unsigned* p, unsigned v) { return __hip_atomic_fetch_add(p, v, __ATOMIC_RELAXED, __HIP_MEMORY_SCOPE_AGENT); }
__device__ __forceinline__ unsigned xb_xcc_id() { return (unsigned)__builtin_amdgcn_s_getreg((3 << 11) | 20) & 0xFu; }
#define XB_SPIN(cond, bar) do { unsigned _sp = 0; while (cond) { __builtin_amdgcn_s_sleep(1); \
    if ((++_sp & 255u) == 0u) { if (xb_ld(&(bar)[XB_TMO])) break; if (_sp > XB_SPIN_CAP) { atomicAdd(&(bar)[XB_TMO], 1u); break; } } } } while (0)
struct XcdBarrier { unsigned* bar; unsigned x; volatile LAS unsigned* st; };
__device__ __forceinline__ XcdBarrier xcd_barrier_post(unsigned* bar, volatile LAS unsigned* st) {
    XcdBarrier b; b.bar = bar; b.x = xb_xcc_id(); b.st = st;
    if (threadIdx.x == 0) (void)xb_add(&bar[XB_XCNT(b.x)], 1u);
    return b;
}
__device__ __forceinline__ void xcd_barrier_complete(unsigned* bar, unsigned x, unsigned& nloc, unsigned& nx) {
    const unsigned G = gridDim.x * gridDim.y * gridDim.z;
    unsigned sum, cnt, mine, sp = 0u;
    for (;;) {
        sum = 0u; cnt = 0u; mine = 0u;
#pragma unroll
        for (unsigned j = 0; j < 16; ++j) { const unsigned c = xb_ld(&bar[XB_XCNT(j)]); sum += c; cnt += (c > 0u) ? 1u : 0u; mine = (j == x) ? c : mine; }
        if (sum == G) break;
        __builtin_amdgcn_s_sleep(1);
        if ((++sp & 255u) == 0u) { if (xb_ld(&bar[XB_TMO])) break; if (sp > XB_SPIN_CAP) { atomicAdd(&bar[XB_TMO], 1u); break; } }
    }
    nloc = mine > 0u ? mine : 1u; nx = cnt > 0u ? cnt : 1u;
}
template <bool BG>
__device__ __forceinline__ void xcd_barrier(const XcdBarrier& b, LAS unsigned char* lds = nullptr) {
    volatile LAS unsigned* bgw = (volatile LAS unsigned*)(lds + MISC_OFF) + 12;
    if (BG && threadIdx.x == 0) bgw[0] = 0u;
    asm volatile("s_waitcnt vmcnt(0)" ::: "memory");
    __syncthreads();
    if (BG && threadIdx.x >= 64) { const int wave_ = __builtin_amdgcn_readfirstlane((int)threadIdx.x >> 6), lane_ = (int)threadIdx.x & 63;
        const unsigned q_ = bg_xcc_id();
        while (bgw[0] == 0u && bgw[1] == 0u) { if (!moe_bg_ticket(lds, wave_, lane_, q_)) { if (lane_ == 0) bgw[1] = 1u; break; } }
        asm volatile("s_waitcnt vmcnt(0)" ::: "memory"); }
    if (threadIdx.x == 0) {
        unsigned* bar = b.bar;
        __builtin_amdgcn_s_waitcnt(0);
        unsigned nloc = b.st[0], nx = b.st[1];
        if (nloc == 0u) { xcd_barrier_complete(bar, b.x, nloc, nx); b.st[0] = nloc; b.st[1] = nx; }
        const unsigned old = xb_add(&bar[XB_XSUB(b.x)], 1u);
        const unsigned gen = old / nloc;
        if (old + 1u == (gen + 1u) * nloc) {
            __builtin_amdgcn_fence(__ATOMIC_RELEASE, "agent");
            asm volatile("s_waitcnt vmcnt(0)" ::: "memory");
            const unsigned og = xb_add(&bar[XB_TOP], 1u);
            const unsigned tg = og / nx;
            if (og + 1u == (tg + 1u) * nx) xb_add(&bar[XB_TOPGEN], 1u);
            else XB_SPIN(xb_ld(&bar[XB_TOPGEN]) == tg, bar);
            __builtin_amdgcn_fence(__ATOMIC_ACQUIRE, "agent");
            xb_add(&bar[XB_XGEN(b.x)], 1u);
            asm volatile("s_waitcnt vmcnt(0)" ::: "memory");
        } else {
            XB_SPIN(xb_ld(&bar[XB_XGEN(b.x)]) == gen, bar);
            __builtin_amdgcn_fence(__ATOMIC_ACQUIRE, "agent");
            asm volatile("s_waitcnt vmcnt(0)" ::: "memory");
        }
        if (BG) bgw[0] = 1u;
    }
    __syncthreads();
}

__device__ __forceinline__ unsigned f2bf(float f) { unsigned u = __builtin_bit_cast(unsigned, f); return (u + 0x7fffu + ((u >> 16) & 1u)) >> 16; }
__device__ __forceinline__ unsigned pk2(float lo, float hi) { return f2bf(lo) | (f2bf(hi) << 16); }
__device__ __forceinline__ void conv_item(const float* W, int ldw, int k0, int n0, bf16* WT, int K, int drow, LAS float* scr, int lane, const float* gk = nullptr) {
#pragma unroll
    for (int i = 0; i < 8; ++i) { const int kk = i * 8 + (lane >> 3), n4 = (lane & 7) * 4;
        f32x4 v = *(const f32x4*)(W + (size_t)(k0 + kk) * ldw + n0 + n4); if (gk) v = v * gk[k0 + kk];
        scr[kk * 33 + n4 + 0] = v[0]; scr[kk * 33 + n4 + 1] = v[1]; scr[kk * 33 + n4 + 2] = v[2]; scr[kk * 33 + n4 + 3] = v[3]; }
    LDS_WAIT(); asm volatile("" ::: "memory");
    const int c = lane & 7;
#pragma unroll
    for (int j = 0; j < 4; ++j) { const int n = (lane >> 3) + 8 * j; const LAS float* s = scr + (8 * c) * 33 + n;
        u32x4 o; o.x = pk2(s[0 * 33], s[1 * 33]); o.y = pk2(s[2 * 33], s[3 * 33]); o.z = pk2(s[4 * 33], s[5 * 33]); o.w = pk2(s[6 * 33], s[7 * 33]);
        *(u32x4*)(WT + (size_t)(drow + n) * K + k0 + 8 * c) = o; }
    LDS_WAIT(); asm volatile("" ::: "memory");
}
__device__ __forceinline__ void conv_item8(const float* W, int ldw, int k0, int n0, unsigned char* WT, int Kb, int drow, float sc, LAS float* scr, int lane) {
#pragma unroll
    for (int i = 0; i < 8; ++i) { const int kk = i * 8 + (lane >> 3), n4 = (lane & 7) * 4;
        const f32x4 v = *(const f32x4*)(W + (size_t)(k0 + kk) * ldw + n0 + n4);
        scr[kk * 33 + n4 + 0] = v[0]; scr[kk * 33 + n4 + 1] = v[1]; scr[kk * 33 + n4 + 2] = v[2]; scr[kk * 33 + n4 + 3] = v[3]; }
    LDS_WAIT(); asm volatile("" ::: "memory");
    const int c = lane & 7;
#pragma unroll
    for (int j = 0; j < 4; ++j) { const int n = (lane >> 3) + 8 * j; const LAS float* s = scr + (8 * c) * 33 + n;
        int w0 = 0, w1 = 0;
        w0 = __builtin_amdgcn_cvt_pk_fp8_f32(s[0 * 33] * sc, s[1 * 33] * sc, w0, false); w0 = __builtin_amdgcn_cvt_pk_fp8_f32(s[2 * 33] * sc, s[3 * 33] * sc, w0, true);
        w1 = __builtin_amdgcn_cvt_pk_fp8_f32(s[4 * 33] * sc, s[5 * 33] * sc, w1, false); w1 = __builtin_amdgcn_cvt_pk_fp8_f32(s[6 * 33] * sc, s[7 * 33] * sc, w1, true);
        *(u32x2*)(WT + (size_t)(drow + n) * Kb + k0 + 8 * c) = (u32x2){(unsigned)w0, (unsigned)w1}; }
    LDS_WAIT(); asm volatile("" ::: "memory");
}
__device__ __forceinline__ int map_win8(int n0) {
    if (n0 < 768) return n0; if (n0 < 832) return (ZC_KPE - ZC_CQ) + (n0 - 768); if (n0 < 2880) return (ZC_QM - ZC_CQ) + (n0 - 1856);
    const int gb = ZC_GATE - ZC_CQ; if (n0 < 4928) return gb + 2048 + (n0 - 2880); if (n0 < 6976) return gb + (n0 - 4928); return gb + 4096 + (n0 - 6976); }
__device__ __forceinline__ int map_ukv(int n0) { const int h = n0 >> 8, j0 = n0 & 255; return j0 < 128 ? h * 128 + j0 : 1024 + h * 128 + (j0 - 128); }
__device__ __forceinline__ int map_gu(int n0, int up) { return (n0 >> 7) * 256 + up * 128 + (n0 & 127); }

struct Args { const void* in[30]; float* out; unsigned char* ws; int ph_lo, ph_hi; };

__device__ __forceinline__ void p_prologue(LAS unsigned char* lds, int gw, int NGW, int wave, int lane) {
    LAS float* scr = (LAS float*)(lds + wave * 16384);
    unsigned char* ws = (unsigned char*)ld_tbl(lds, 31);
    constexpr int I_IN = 32 * 282, I_UQ = 8 * 48, I_UKV = 4 * 64, I_MO = 16 * 64, I_PW = 4 * 8, I_MKV = 32 * 64, I_WO = 32 * 64;
    constexpr int I_DG = 32 * 176, I_DD = 88 * 64, I_MG = 32 * 224, I_MDN = 112 * 64;
    constexpr long NITEMS = 2L * (I_IN + I_UQ + I_UKV + I_MO + 4 * I_PW + I_MO + I_MKV + I_MO + I_WO) + 2 * I_DG + I_DD;
    unsigned* ticket = (unsigned*)(ws + WS_CTL) + 64;
    for (;;) { unsigned tk = 0; if (lane == 0) tk = __hip_atomic_fetch_add(ticket, 1u, __ATOMIC_RELAXED, __HIP_MEMORY_SCOPE_AGENT);
      const long it0 = 8L * (long)__builtin_amdgcn_readfirstlane((int)tk);
      if (it0 >= NITEMS) break;
      for (long it = it0; it < it0 + 8 && it < NITEMS; ++it) {
        long r = it;
#define CONV_LG(cnt, IDX, Kd, Nd, DST, DROWS, MAP, GK) if (r < 2L * (cnt)) { const int l = (int)(r / (cnt)); const int q = (int)(r % (cnt)); const int nblk = (Nd) / 32, kb = q / nblk, nb = q % nblk; \
            conv_item(INF(IDX) + (size_t)l * (Kd) * (Nd), (Nd), 64 * kb, 32 * nb, (bf16*)(ws + (DST)) + (size_t)l * (DROWS) * (Kd), (Kd), MAP, scr, lane, GK); continue; } r -= 2L * (cnt);
#define CONV_L(cnt, IDX, Kd, Nd, DST, DROWS, MAP) CONV_LG(cnt, IDX, Kd, Nd, DST, DROWS, MAP, nullptr)
        if (r < 2L * I_IN) { const int l = (int)(r / I_IN), q = (int)(r % I_IN), kb = q / 282, nb = q % 282, n0 = 32 * nb;
            if (n0 >= 832 && n0 < 1856) conv_item(INF(4) + (size_t)l * 2048 * INW, INW, 64 * kb, n0, (bf16*)(ws + WS_W_IN) + (size_t)l * ZNB * 2048, 2048, n0 - 832, scr, lane);
            else conv_item8(INF(4) + (size_t)l * 2048 * INW, INW, 64 * kb, n0, ws + WS_W_IN8 + (size_t)l * ZN8 * 2048, 2048, map_win8(n0), GATE_WSC, scr, lane);
            continue; } r -= 2L * I_IN;
        CONV_LG(I_UQ, 6, 512, 1536, WS_W_UQ, 1536, 32 * nb, INF(5) + l * 512)
        CONV_LG(I_UKV, 8, 256, 2048, WS_W_UKV, 2048, map_ukv(32 * nb), INF(7) + l * 256)
        CONV_L(I_MO, 11, 1024, 2048, WS_W_MLAOUT, 2048, 32 * nb)
        if (r < 2L * 4 * I_PW) { const int lg = (int)(r / I_PW), q = (int)(r % I_PW), kb = q / 8, nb = q % 8;
            conv_item(INF(12) + (size_t)lg * 65536, 256, 64 * kb, 32 * nb, (bf16*)(ws + WS_W_POOL), 256, lg * 256 + 32 * nb, scr, lane); continue; } r -= 2L * 4 * I_PW;
        CONV_L(I_MO, 14, 1024, 2048, WS_W_POOLOUT, 2048, 32 * nb)
        CONV_L(I_MKV, 16, 2048, 2048, WS_W_MEMKV, 2048, 32 * nb)
        CONV_L(I_MO, 19, 1024, 2048, WS_W_MEMOUT, 2048, 32 * nb)
        CONV_L(I_WO, 20, 2048, 2048, WS_W_O, 2048, 32 * nb)
#undef CONV_L
#undef CONV_LG
        if (r < 2L * I_DG) { const int up = (int)(r / I_DG), q = (int)(r % I_DG), kb = q / 176, nb = q % 176;
            conv_item(INF(22 + up), DFF, 64 * kb, 32 * nb, (bf16*)(ws + WS_W_DGU), 2048, map_gu(32 * nb, up), scr, lane); continue; } r -= 2L * I_DG;
        if (r < I_DD) { const int q = (int)r, kb = q / 64, nb = q % 64;
            conv_item(INF(24), 2048, 64 * kb, 32 * nb, (bf16*)(ws + WS_W_DD), DFF, 32 * nb, scr, lane); continue; } r -= I_DD;
      }
    }
    for (int i = gw; i < 2 * 192; i += NGW) { const int l = i / 192, rr = (ZC_KPE - ZC_CQ) + 64 + i % 192; u32x4* p = (u32x4*)(ws + WS_W_IN8 + ((size_t)l * ZN8 + rr) * 2048);
#pragma unroll
        for (int j = 0; j < 2; ++j) p[lane + 64 * j] = (u32x4){0u, 0u, 0u, 0u}; }
    float* ct = (float*)(ws + WS_ROPE); float* st = ct + (size_t)T * 32;
    const int* pos = (const int*)ld_tbl(lds, 2);
    for (int i = gw * 64 + lane; i < T * 32; i += NGW * 64) { const int t = i >> 5, f = i & 31;
        const float inv_freq = powf(10000.0f, -(float)(2 * f) / 64.0f);
        const float ang = (float)pos[t] * inv_freq;
        const double rev = (double)ang * 0.15915494309189535; const float fr = (float)(rev - rint(rev));
        ct[i] = __builtin_amdgcn_cosf(fr); st[i] = __builtin_amdgcn_sinf(fr); }
}

__device__ __forceinline__ void norm_row_2048(const float* xrow, const float* g, bf16* orow, unsigned char* orow8, int lane) {
    f32x4 v[8]; float s = 0.f;
#pragma unroll
    for (int j = 0; j < 8; ++j) { v[j] = ((const f32x4*)xrow)[lane + 64 * j]; s += (v[j][0] * v[j][0] + v[j][1] * v[j][1]) + (v[j][2] * v[j][2] + v[j][3] * v[j][3]); }
    const float rinv = 1.0f / sqrtf(wave_sum(s) * (1.0f / 2048.0f) + EPS);
#pragma unroll
    for (int j = 0; j < 8; ++j) { const f32x4 gv = ((const f32x4*)g)[lane + 64 * j]; const f32x4 o = v[j] * rinv * gv;
        u32x2 w; w.x = cvt_pk_bf16(o[0], o[1]); w.y = cvt_pk_bf16(o[2], o[3]); ((u32x2*)orow)[lane + 64 * j] = w;
        if (orow8) { int w8 = 0; w8 = __builtin_amdgcn_cvt_pk_fp8_f32(o[0], o[1], w8, false); w8 = __builtin_amdgcn_cvt_pk_fp8_f32(o[2], o[3], w8, true); ((unsigned*)orow8)[lane + 64 * j] = (unsigned)w8; } }
}
__device__ __forceinline__ void p_norm(const float* y, const float* g, bf16* H, unsigned char* H8, const float* mem, const float* gm, bf16* MEMN, int gw, int NGW, int lane) {
    for (int m = gw; m < T; m += NGW) norm_row_2048(y + (size_t)m * DM, g, H + (size_t)m * DM, H8 ? H8 + (size_t)m * DM : nullptr, lane);
    if (mem) for (int m = gw; m < MROWS; m += NGW) norm_row_2048(mem + (size_t)m * DM, gm, MEMN + (size_t)m * DM, nullptr, lane);
}
__device__ __forceinline__ void p_postz(const bf16* Z, float* RS, float* RQ, bf16* POOLED, int gw, int NGW, int lane) {
    for (int t = gw; t < T; t += NGW) {
        const bf16* zr = Z + (size_t)t * ZW;
        {
            const u32x2 w = *(const u32x2*)(zr + ZC_CKV + 4 * lane);
            const float x0 = bf_lo(w.x), x1 = bf_hi(w.x), x2 = bf_lo(w.y), x3 = bf_hi(w.y);
            const float ss = wave_sum(x0 * x0 + x1 * x1 + x2 * x2 + x3 * x3);
            if (lane == 0) RS[t] = 1.0f / sqrtf(ss * (1.0f / 256.0f) + EPS);
        }
        {
            const u32x4 w0 = *(const u32x4*)(zr + ZC_QM + 16 * lane), w1 = *(const u32x4*)(zr + ZC_QM + 16 * lane + 8);
            const float x[16] = {bf_lo(w0.x), bf_hi(w0.x), bf_lo(w0.y), bf_hi(w0.y), bf_lo(w0.z), bf_hi(w0.z), bf_lo(w0.w), bf_hi(w0.w),
                                 bf_lo(w1.x), bf_hi(w1.x), bf_lo(w1.y), bf_hi(w1.y), bf_lo(w1.z), bf_hi(w1.z), bf_lo(w1.w), bf_hi(w1.w)};
            float ss = 0.f;
#pragma unroll
            for (int j = 0; j < 16; ++j) ss += x[j] * x[j];
            ss += __shfl_xor(ss, 1); ss += __shfl_xor(ss, 2); ss += __shfl_xor(ss, 4); ss += __shfl_xor(ss, 8);
            if ((lane & 15) == 0) RQ[4 * t + (lane >> 4)] = (1.0f / sqrtf(ss * (1.0f / 256.0f) + EPS)) * (0.0625f * LOG2E);
        }
        {
            const int s = t & (SEQ - 1), grp = lane >> 4, w = 2 << grp, n = (s + 1) < w ? (s + 1) : w;
            u32x4 ra[16], rb[16];
#pragma unroll
            for (int d = 0; d < 16; ++d) { ra[d] = (u32x4){0u, 0u, 0u, 0u}; rb[d] = (u32x4){0u, 0u, 0u, 0u};
                if (d < n) { const bf16* ur = zr - (size_t)d * ZW + ZC_POOL + 16 * lane; ra[d] = *(const u32x4*)ur; rb[d] = *(const u32x4*)(ur + 8); } }
            float acc[16], own[16];
#pragma unroll
            for (int j = 0; j < 16; ++j) acc[j] = 0.f;
#pragma unroll
            for (int d = 0; d < 16; ++d) { const u32x4 w0 = ra[d], w1 = rb[d];
                const float x[16] = {bf_lo(w0.x), bf_hi(w0.x), bf_lo(w0.y), bf_hi(w0.y), bf_lo(w0.z), bf_hi(w0.z), bf_lo(w0.w), bf_hi(w0.w),
                                     bf_lo(w1.x), bf_hi(w1.x), bf_lo(w1.y), bf_hi(w1.y), bf_lo(w1.z), bf_hi(w1.z), bf_lo(w1.w), bf_hi(w1.w)};
#pragma unroll
                for (int j = 0; j < 16; ++j) { acc[j] += x[j]; if (d == 0) own[j] = x[j]; } }
            const float rn = 1.0f / (float)n; unsigned o[8];
#pragma unroll
            for (int j = 0; j < 8; ++j) o[j] = cvt_pk_bf16(acc[2 * j] * rn - own[2 * j], acc[2 * j + 1] * rn - own[2 * j + 1]);
            bf16* pr = POOLED + (size_t)t * 1024 + 16 * lane;
            *(u32x4*)pr = (u32x4){o[0], o[1], o[2], o[3]}; *(u32x4*)(pr + 8) = (u32x4){o[4], o[5], o[6], o[7]};
        }
    }
}
__device__ __forceinline__ void p_postqkv(bf16* QB, const bf16* KNOPE, const bf16* Z, bf16* KB, bf16* KM, const float* gq, const float* gk, const float* gkm, const float* gqm,
                                          const float* ct, const float* st, int gw, int NGW, int lane) {
    const int h = lane >> 3, j8 = lane & 7;
    for (int t = gw; t < T; t += NGW) {
        const f32x4 cs = *(const f32x4*)(ct + (size_t)t * 32 + 4 * j8), sn = *(const f32x4*)(st + (size_t)t * 32 + 4 * j8);
        {
            bf16* qr = QB + (size_t)t * 1536 + h * 192;
            const u32x4 w0 = *(const u32x4*)(qr + 16 * j8), w1 = *(const u32x4*)(qr + 16 * j8 + 8);
            const u32x2 r1 = *(const u32x2*)(qr + 128 + 4 * j8), r2 = *(const u32x2*)(qr + 160 + 4 * j8);
            float x[16] = {bf_lo(w0.x), bf_hi(w0.x), bf_lo(w0.y), bf_hi(w0.y), bf_lo(w0.z), bf_hi(w0.z), bf_lo(w0.w), bf_hi(w0.w),
                           bf_lo(w1.x), bf_hi(w1.x), bf_lo(w1.y), bf_hi(w1.y), bf_lo(w1.z), bf_hi(w1.z), bf_lo(w1.w), bf_hi(w1.w)};
            float a[4] = {bf_lo(r1.x), bf_hi(r1.x), bf_lo(r1.y), bf_hi(r1.y)}, b[4] = {bf_lo(r2.x), bf_hi(r2.x), bf_lo(r2.y), bf_hi(r2.y)};
            float s = 0.f;
#pragma unroll
            for (int j = 0; j < 16; ++j) s += x[j] * x[j];
#pragma unroll
            for (int j = 0; j < 4; ++j) s += a[j] * a[j] + b[j] * b[j];
            s += __shfl_xor(s, 1); s += __shfl_xor(s, 2); s += __shfl_xor(s, 4);
            const float rinv = (1.0f / sqrtf(s * (1.0f / 192.0f) + EPS)) * (0.07216878364870322f * LOG2E);
            unsigned o[8];
#pragma unroll
            for (int j = 0; j < 8; ++j) o[j] = cvt_pk_bf16(x[2 * j] * rinv * gq[16 * j8 + 2 * j], x[2 * j + 1] * rinv * gq[16 * j8 + 2 * j + 1]);
            *(u32x4*)(qr + 16 * j8) = (u32x4){o[0], o[1], o[2], o[3]}; *(u32x4*)(qr + 16 * j8 + 8) = (u32x4){o[4], o[5], o[6], o[7]};
            float y1[4], y2[4];
#pragma unroll
            for (int j = 0; j < 4; ++j) { const float x1 = a[j] * rinv * gq[128 + 4 * j8 + j], x2 = b[j] * rinv * gq[160 + 4 * j8 + j]; y1[j] = x1 * cs[j] - x2 * sn[j]; y2[j] = x2 * cs[j] + x1 * sn[j]; }
            *(u32x2*)(qr + 128 + 4 * j8) = (u32x2){cvt_pk_bf16(y1[0], y1[1]), cvt_pk_bf16(y1[2], y1[3])};
            *(u32x2*)(qr + 160 + 4 * j8) = (u32x2){cvt_pk_bf16(y2[0], y2[1]), cvt_pk_bf16(y2[2], y2[3])};
        }
        {
            const bf16* kn = KNOPE + (size_t)t * 1024 + h * 128 + 16 * j8; const bf16* kp = Z + (size_t)t * ZW + ZC_KPE;
            const u32x4 w0 = *(const u32x4*)kn, w1 = *(const u32x4*)(kn + 8);
            const u32x2 r1 = *(const u32x2*)(kp + 4 * j8), r2 = *(const u32x2*)(kp + 32 + 4 * j8);
            float x[16] = {bf_lo(w0.x), bf_hi(w0.x), bf_lo(w0.y), bf_hi(w0.y), bf_lo(w0.z), bf_hi(w0.z), bf_lo(w0.w), bf_hi(w0.w),
                           bf_lo(w1.x), bf_hi(w1.x), bf_lo(w1.y), bf_hi(w1.y), bf_lo(w1.z), bf_hi(w1.z), bf_lo(w1.w), bf_hi(w1.w)};
            float a[4] = {bf_lo(r1.x), bf_hi(r1.x), bf_lo(r1.y), bf_hi(r1.y)}, b[4] = {bf_lo(r2.x), bf_hi(r2.x), bf_lo(r2.y), bf_hi(r2.y)};
            float s = 0.f;
#pragma unroll
            for (int j = 0; j < 16; ++j) s += x[j] * x[j];
#pragma unroll
            for (int j = 0; j < 4; ++j) s += a[j] * a[j] + b[j] * b[j];
            s += __shfl_xor(s, 1); s += __shfl_xor(s, 2); s += __shfl_xor(s, 4);
            const float rinv = 1.0f / sqrtf(s * (1.0f / 192.0f) + EPS);
            bf16* kr = KB + (size_t)t * 1536 + h * 192;
            unsigned o[8];
#pragma unroll
            for (int j = 0; j < 8; ++j) o[j] = cvt_pk_bf16(x[2 * j] * rinv * gk[16 * j8 + 2 * j], x[2 * j + 1] * rinv * gk[16 * j8 + 2 * j + 1]);
            *(u32x4*)(kr + 16 * j8) = (u32x4){o[0], o[1], o[2], o[3]}; *(u32x4*)(kr + 16 * j8 + 8) = (u32x4){o[4], o[5], o[6], o[7]};
            float y1[4], y2[4];
#pragma unroll
            for (int j = 0; j < 4; ++j) { const float x1 = a[j] * rinv * gk[128 + 4 * j8 + j], x2 = b[j] * rinv * gk[160 + 4 * j8 + j]; y1[j] = x1 * cs[j] - x2 * sn[j]; y2[j] = x2 * cs[j] + x1 * sn[j]; }
            *(u32x2*)(kr + 128 + 4 * j8) = (u32x2){cvt_pk_bf16(y1[0], y1[1]), cvt_pk_bf16(y1[2], y1[3])};
            *(u32x2*)(kr + 160 + 4 * j8) = (u32x2){cvt_pk_bf16(y2[0], y2[1]), cvt_pk_bf16(y2[2], y2[3])};
        }
    }
    for (int m = gw; m < MROWS; m += NGW) {
        bf16* kr = KM + (size_t)m * 1024 + 16 * lane;
        const u32x4 w0 = *(const u32x4*)kr, w1 = *(const u32x4*)(kr + 8);
        float x[16] = {bf_lo(w0.x), bf_hi(w0.x), bf_lo(w0.y), bf_hi(w0.y), bf_lo(w0.z), bf_hi(w0.z), bf_lo(w0.w), bf_hi(w0.w),
                       bf_lo(w1.x), bf_hi(w1.x), bf_lo(w1.y), bf_hi(w1.y), bf_lo(w1.z), bf_hi(w1.z), bf_lo(w1.w), bf_hi(w1.w)};
        float s = 0.f;
#pragma unroll
        for (int j = 0; j < 16; ++j) s += x[j] * x[j];
        s += __shfl_xor(s, 1); s += __shfl_xor(s, 2); s += __shfl_xor(s, 4); s += __shfl_xor(s, 8);
        const float rinv = 1.0f / sqrtf(s * (1.0f / 256.0f) + EPS);
        const float* gp = gkm + 16 * (lane & 15); const float* gq2 = gqm + 16 * (lane & 15);
        unsigned o[8];
#pragma unroll
        for (int j = 0; j < 8; ++j) o[j] = cvt_pk_bf16(x[2 * j] * rinv * gp[2 * j] * gq2[2 * j], x[2 * j + 1] * rinv * gp[2 * j + 1] * gq2[2 * j + 1]);
        *(u32x4*)kr = (u32x4){o[0], o[1], o[2], o[3]}; *(u32x4*)(kr + 8) = (u32x4){o[4], o[5], o[6], o[7]};
    }
}

template <int DQK, bool CAUSAL, bool STAG>
__device__ __forceinline__ void attn_unit(LAS unsigned char* lds, const bf16* Qp, int qpitch, const bf16* Kp, int kpitch, const bf16* Vtp, int vpitch,
                                          bf16* Op, int opitch, int q0, int ntiles, const float* rowscale = nullptr, int rs_stride = 0) {
    constexpr int NS = DQK / 16, KRS = DQK * 2 + 16, KTB = 64 * KRS, VRS = 136, VTB = 128 * VRS, KPR = DQK / 8, NKP = 64 * KPR / 512;
    const int tid = launder_i(threadIdx.x), wid = __builtin_amdgcn_readfirstlane(tid >> 6), lane = tid & 63, c = lane & 31, hi = lane >> 5;
    bf16x8 qr[NS];
    { const bf16* qrow = Qp + (size_t)(32 * wid + c) * qpitch + 8 * hi;
#pragma unroll
      for (int s = 0; s < NS; ++s) qr[s] = *(const bf16x8*)(qrow + 16 * s); }
    u32x4 kst[NKP], vst[2];
    int krow[NKP], kcc[NKP];
#pragma unroll
    for (int i = 0; i < NKP; ++i) { const int p = tid + 512 * i; krow[i] = p / KPR; kcc[i] = p % KPR; }
    const int vrow0 = tid >> 3, vcc = tid & 7;
#define AT_ISSUE(j) do { _Pragma("unroll") for (int i = 0; i < NKP; ++i) kst[i] = *(const u32x4*)(Kp + (size_t)(64 * (j) + krow[i]) * kpitch + kcc[i] * 8); \
        _Pragma("unroll") for (int i = 0; i < 2; ++i) vst[i] = *(const u32x4*)(Vtp + (size_t)(vrow0 + 64 * i) * vpitch + 64 * (j) + vcc * 8); } while (0)
#define AT_WRITE(b) do { _Pragma("unroll") for (int i = 0; i < NKP; ++i) *(LAS u32x4*)(lds + (b) * KTB + krow[i] * KRS + kcc[i] * 16) = kst[i]; \
        _Pragma("unroll") for (int i = 0; i < 2; ++i) { LAS unsigned char* vp = lds + 2 * KTB + (b) * VTB + (vrow0 + 64 * i) * VRS + vcc * 16; \
            *(LAS u32x2*)vp = (u32x2){vst[i].x, vst[i].y}; *(LAS u32x2*)(vp + 8) = (u32x2){vst[i].z, vst[i].w}; } } while (0)
    f32x16 o[4];
#pragma unroll
    for (int d = 0; d < 4; ++d)
#pragma unroll
        for (int r = 0; r < 16; ++r) o[d][r] = 0.f;
    float m_run = -1e30f, l_run = 0.f;
    const int qpos = q0 + 32 * wid + c;
    const float rsc = rowscale ? rowscale[(size_t)(32 * wid + c) * rs_stride] : 1.0f;
    const bool grpB = STAG && wid >= 4;
    bf16x8 pf[4];
#pragma unroll
    for (int i = 0; i < 4; ++i) pf[i] = (bf16x8){0, 0, 0, 0, 0, 0, 0, 0};
#define AT_PV(vbuf) do { const LAS unsigned char* vb = lds + 2 * KTB + (vbuf) * VTB + c * VRS + hi * 8; \
        _Pragma("unroll") for (int d = 0; d < 4; ++d) _Pragma("unroll") for (int ks = 0; ks < 4; ++ks) { \
            const u32x2 lo = *(const LAS u32x2*)(vb + d * 32 * VRS + ks * 32), h8 = *(const LAS u32x2*)(vb + d * 32 * VRS + ks * 32 + 16); \
            const u32x4 av = {lo.x, lo.y, h8.x, h8.y}; \
            o[d] = __builtin_amdgcn_mfma_f32_32x32x16_bf16(__builtin_bit_cast(bf16x8, av), pf[ks], o[d], 0, 0, 0); } } while (0)
#define AT_ACTIVE(j) (!CAUSAL || (64 * (j) <= q0 + 32 * wid + 31))
    AT_ISSUE(0);
#pragma unroll
    for (int i = 0; i < NKP; ++i) *(LAS u32x4*)(lds + krow[i] * KRS + kcc[i] * 16) = kst[i];
#pragma unroll
    for (int i = 0; i < 2; ++i) { LAS unsigned char* vp = lds + 2 * KTB + (vrow0 + 64 * i) * VRS + vcc * 16; *(LAS u32x2*)vp = (u32x2){vst[i].x, vst[i].y}; *(LAS u32x2*)(vp + 8) = (u32x2){vst[i].z, vst[i].w}; }
    __syncthreads();
    int vcur = 0;
    for (int j = 0; j < ntiles; ++j) {
        const int b = j & 1, vprev = vcur == 0 ? 2 : vcur - 1, vnext = vcur == 2 ? 0 : vcur + 1;
        if (j + 1 < ntiles) AT_ISSUE(j + 1);
        if (grpB && j > 0 && AT_ACTIVE(j - 1)) AT_PV(vprev);
        if (AT_ACTIVE(j)) {
            f32x16 p0, p1;
#pragma unroll
            for (int r = 0; r < 16; ++r) { p0[r] = 0.f; p1[r] = 0.f; }
            const LAS unsigned char* kb = lds + b * KTB + c * KRS + hi * 16;
#pragma unroll
            for (int s = 0; s < NS; ++s) {
                const bf16x8 a0 = *(const LAS bf16x8*)(kb + 32 * s), a1 = *(const LAS bf16x8*)(kb + 32 * KRS + 32 * s);
                p0 = __builtin_amdgcn_mfma_f32_32x32x16_bf16(a0, qr[s], p0, 0, 0, 0);
                p1 = __builtin_amdgcn_mfma_f32_32x32x16_bf16(a1, qr[s], p1, 0, 0, 0);
                if (DQK > 192 && (s & 3) == 3) __builtin_amdgcn_sched_barrier(0);
            }
            if (rowscale) {
#pragma unroll
                for (int r = 0; r < 16; ++r) { p0[r] *= rsc; p1[r] *= rsc; } }
            if (CAUSAL && (64 * j + 63 > q0 + 32 * wid)) {
                const float NEG = -__builtin_inff();
#pragma unroll
                for (int r = 0; r < 16; ++r) { const int key = 64 * j + (r & 3) + 8 * (r >> 2) + 4 * hi;
                    if (key > qpos) p0[r] = NEG; if (key + 32 > qpos) p1[r] = NEG; }
            }
            float mx = p0[0];
#pragma unroll
            for (int r = 1; r < 16; ++r) mx = fmaxf(mx, p0[r]);
#pragma unroll
            for (int r = 0; r < 16; ++r) mx = fmaxf(mx, p1[r]);
            mx = fmaxf(mx, __shfl_xor(mx, 32));
            const float mnew = fmaxf(m_run, mx), alpha = __builtin_amdgcn_exp2f(m_run - mnew);
            m_run = mnew;
            float ps = 0.f;
#pragma unroll
            for (int r = 0; r < 16; ++r) { p0[r] = __builtin_amdgcn_exp2f(p0[r] - mnew); p1[r] = __builtin_amdgcn_exp2f(p1[r] - mnew); ps += p0[r] + p1[r]; }
            l_run = l_run * alpha + ps;
            if (__any(alpha != 1.0f)) {
#pragma unroll
                for (int d = 0; d < 4; ++d)
#pragma unroll
                    for (int r = 0; r < 16; ++r) o[d][r] *= alpha;
            }
#pragma unroll
            for (int s = 0; s < 2; ++s) {
                u32x4 w0 = {cvt_pk_bf16(p0[8 * s + 0], p0[8 * s + 1]), cvt_pk_bf16(p0[8 * s + 2], p0[8 * s + 3]), cvt_pk_bf16(p0[8 * s + 4], p0[8 * s + 5]), cvt_pk_bf16(p0[8 * s + 6], p0[8 * s + 7])};
                u32x4 w1 = {cvt_pk_bf16(p1[8 * s + 0], p1[8 * s + 1]), cvt_pk_bf16(p1[8 * s + 2], p1[8 * s + 3]), cvt_pk_bf16(p1[8 * s + 4], p1[8 * s + 5]), cvt_pk_bf16(p1[8 * s + 6], p1[8 * s + 7])};
                pf[s] = __builtin_bit_cast(bf16x8, w0); pf[2 + s] = __builtin_bit_cast(bf16x8, w1);
            }
            if (!grpB) AT_PV(vcur);
        }
        if (j + 1 < ntiles) {
#pragma unroll
            for (int i = 0; i < NKP; ++i) *(LAS u32x4*)(lds + (b ^ 1) * KTB + krow[i] * KRS + kcc[i] * 16) = kst[i];
#pragma unroll
            for (int i = 0; i < 2; ++i) { LAS unsigned char* vp = lds + 2 * KTB + vnext * VTB + (vrow0 + 64 * i) * VRS + vcc * 16; *(LAS u32x2*)vp = (u32x2){vst[i].x, vst[i].y}; *(LAS u32x2*)(vp + 8) = (u32x2){vst[i].z, vst[i].w}; }
        }
        __syncthreads();
        vcur = vnext;
    }
    if (grpB && AT_ACTIVE(ntiles - 1)) { const int vlast = vcur == 0 ? 2 : vcur - 1; AT_PV(vlast); }
#undef AT_PV
#undef AT_ACTIVE
    const float lt = l_run + __shfl_xor(l_run, 32), inv = 1.0f / lt;
    bf16* orow = Op + (size_t)(32 * wid + c) * opitch + 4 * hi;
#pragma unroll
    for (int d = 0; d < 4; ++d)
#pragma unroll
        for (int g = 0; g < 4; ++g) {
            u32x2 w; w.x = cvt_pk_bf16(o[d][4 * g + 0] * inv, o[d][4 * g + 1] * inv); w.y = cvt_pk_bf16(o[d][4 * g + 2] * inv, o[d][4 * g + 3] * inv);
            *(u32x2*)(orow + 32 * d + 8 * g) = w;
        }
    __syncthreads();
#undef AT_ISSUE
#undef AT_WRITE
}
__device__ __forceinline__ void p_attention(LAS unsigned char* lds, unsigned char* ws, int G, int bid) {
    const bf16* QB = (const bf16*)(ws + WS_QB); const bf16* KB = (const bf16*)(ws + WS_KB); const bf16* VT = (const bf16*)(ws + WS_VT); bf16* OMLA = (bf16*)(ws + WS_OMLA);
    const bf16* Z = (const bf16*)(ws + WS_Z); const bf16* KM = (const bf16*)(ws + WS_KM); const bf16* VMT = (const bf16*)(ws + WS_VMT); bf16* OMEM = (bf16*)(ws + WS_OMEM);
#ifndef ATT_SKIP_MLA
    for (int it = bid; it < 256; it += G) {
        const int bh = it >> 2, p = it & 3, b = bh >> 3, h = bh & 7;
#pragma unroll 1
        for (int pass = 0; pass < 2; ++pass) {
            const int qb = pass ? 7 - p : p, q0 = qb * 256;
            attn_unit<192, true, true>(lds, QB + ((size_t)(b * SEQ + q0)) * 1536 + h * 192, 1536, KB + (size_t)(b * SEQ) * 1536 + h * 192, 1536,
                                 VT + (size_t)(h * 128) * T + b * SEQ, T, OMLA + (size_t)(b * SEQ + q0) * 1024 + h * 128, 1024, q0, (q0 + 256) / 64);
        }
    }
#endif
#ifndef ATT_SKIP_MEM
    for (int it = bid; it < 512; it += G) {
        const int dh = it & 1, qb = (it >> 1) & 7, h = (it >> 4) & 3, b = it >> 6, q0 = qb * 256;
        attn_unit<256, false, false>(lds, Z + (size_t)(b * SEQ + q0) * ZW + ZC_QM + h * 256, ZW, KM + (size_t)(b * MEMT) * 1024 + h * 256, 1024,
                              VMT + (size_t)(h * 256 + dh * 128) * MROWS + b * MEMT, MROWS, OMEM + (size_t)(b * SEQ + q0) * 1024 + h * 256 + dh * 128, 1024, q0, 4, (const float*)(ws + WS_MOE + MO_RQ) + (size_t)(b * SEQ + q0) * 4 + h, 4);
    }
#endif
}

__device__ __forceinline__ void p_ffnnorm_router(LAS unsigned char* lds, const float* y, const float* g, bf16* H, const float* rw, const float* rb,
                                                 int* toke, float* tokw, int* hist, int G, int bid, int tid, int wave, int lane) {
    LAS float* rwl = (LAS float*)lds;
    LAS int* ce = (LAS int*)(lds + 65536);
    for (int idx = tid; idx < 2048 * 8; idx += 512) { const int k = idx >> 3, e = idx & 7; rwl[e * 2048 + k] = rw[idx]; }
    __syncthreads();
    for (int c = bid; c < 256; c += G) {
        for (int i = 0; i < 8; ++i) {
            const int tl = 8 * wave + i, t = 64 * c + tl;
            const float* xrow = y + (size_t)t * DM;
            f32x4 v[8]; float s = 0.f;
#pragma unroll
            for (int j = 0; j < 8; ++j) { v[j] = ((const f32x4*)xrow)[lane + 64 * j]; s += (v[j][0] * v[j][0] + v[j][1] * v[j][1]) + (v[j][2] * v[j][2] + v[j][3] * v[j][3]); }
            const float rinv = 1.0f / sqrtf(wave_sum(s) * (1.0f / 2048.0f) + EPS);
            bf16* orow = H + (size_t)t * DM;
#pragma unroll
            for (int j = 0; j < 8; ++j) { const f32x4 gv = ((const f32x4*)g)[lane + 64 * j]; v[j] = v[j] * rinv * gv;
                u32x2 w; w.x = cvt_pk_bf16(v[j][0], v[j][1]); w.y = cvt_pk_bf16(v[j][2], v[j][3]); ((u32x2*)orow)[lane + 64 * j] = w; }
            float lg[8];
#pragma unroll
            for (int e = 0; e < 8; ++e) { float a = 0.f;
#pragma unroll
                for (int j = 0; j < 8; ++j) { const f32x4 w = *(const LAS f32x4*)(rwl + e * 2048 + 4 * (lane + 64 * j)); a += (v[j][0] * w[0] + v[j][1] * w[1]) + (v[j][2] * w[2] + v[j][3] * w[3]); }
                lg[e] = wave_sum(a) + rb[e]; }
            int e0 = 0; float l0 = lg[0];
#pragma unroll
            for (int e = 1; e < 8; ++e) if (lg[e] > l0) { l0 = lg[e]; e0 = e; }
            int e1 = -1; float l1 = -3.0e38f;
#pragma unroll
            for (int e = 0; e < 8; ++e) if (e != e0 && lg[e] > l1) { l1 = lg[e]; e1 = e; }
            const float g1 = 1.0f / (1.0f + expf(l0 - l1)), g0 = 1.0f - g1;
            if (lane == 0) { toke[2 * t] = e0; toke[2 * t + 1] = e1; tokw[2 * t] = g0; tokw[2 * t + 1] = g1; ce[2 * tl] = e0; ce[2 * tl + 1] = e1; }
        }
        __syncthreads();
        if (wave == 0) { const int e0 = ce[2 * lane], e1 = ce[2 * lane + 1]; int mine = 0;
#pragma unroll
            for (int e = 0; e < 8; ++e) { const int cnt = __popcll(__ballot(e0 == e)) + __popcll(__ballot(e1 == e)); if (lane == e) mine = cnt; }
            if (lane < 8) hist[c * 8 + lane] = mine; }
        __syncthreads();
    }
}
__device__ __forceinline__ void p_moe_assign(LAS unsigned char* lds, const bf16* H, const int* toke, const int* hist, int* toks, int* tilee, unsigned char* XG,
                                             int G, int bid, int tid, int wave, int lane) {
    LAS int* hl = (LAS int*)lds;
    LAS int* ps = (LAS int*)(lds + 8192);
    LAS int* cs = (LAS int*)(lds + 8192 + 64);
    for (int i = tid; i < 2048; i += 512) hl[i] = ld_agent_i(hist + i);
    __syncthreads();
    if (tid < 8) { int run = 0; for (int c = 0; c < 256; ++c) { const int v = hl[c * 8 + tid]; hl[c * 8 + tid] = run; run += v; } ps[8 + tid] = (run + 255) & ~255; }
    __syncthreads();
    if (tid == 0) { int p = 0; for (int e = 0; e < 8; ++e) { ps[e] = p; p += ps[8 + e]; }
        if (bid == 0) { int nt = 0; for (int e = 0; e < 8; ++e) { const int n = ps[8 + e] >> 8; for (int i = 0; i < n; ++i) tilee[nt + i] = e; nt += n; } tilee[MAXTILES] = nt; } }
    __syncthreads();
    for (int c = bid; c < 256; c += G) {
        if (wave == 0) { const int t = 64 * c + lane; const int e0 = toke[2 * t], e1 = toke[2 * t + 1]; int s0 = 0, s1 = 0;
            const unsigned long long lt = (1ull << lane) - 1ull;
#pragma unroll
            for (int e = 0; e < 8; ++e) { const unsigned long long b0 = __ballot(e0 == e), b1 = __ballot(e1 == e);
                const int below = __popcll(b0 & lt) + __popcll(b1 & lt), base = ps[e] + hl[c * 8 + e] + below;
                if (e0 == e) s0 = base; if (e1 == e) s1 = base; }
            toks[2 * t] = s0; toks[2 * t + 1] = s1; cs[2 * lane] = s0; cs[2 * lane + 1] = s1; }
        __syncthreads();
        for (int i = 0; i < 16; ++i) { const int a = 16 * wave + i, tl = a >> 1, slot = cs[a];
            const u32x4* src = (const u32x4*)(H + (size_t)(64 * c + tl) * DM); u32x2* dst = (u32x2*)(XG + (size_t)slot * DM);
#pragma unroll
            for (int j = 0; j < 4; ++j) { const u32x4 w = src[lane + 64 * j]; int w0 = 0, w1 = 0;
                w0 = __builtin_amdgcn_cvt_pk_fp8_f32(bf_lo(w.x), bf_hi(w.x), w0, false); w0 = __builtin_amdgcn_cvt_pk_fp8_f32(bf_lo(w.y), bf_hi(w.y), w0, true);
                w1 = __builtin_amdgcn_cvt_pk_fp8_f32(bf_lo(w.z), bf_hi(w.z), w1, false); w1 = __builtin_amdgcn_cvt_pk_fp8_f32(bf_lo(w.w), bf_hi(w.w), w1, true);
                dst[lane + 64 * j] = (u32x2){(unsigned)w0, (unsigned)w1}; } }
        __syncthreads();
    }
}
__device__ __forceinline__ void p_moe_combine(float* y, const bf16* YS, const int* toks, const float* tokw, int gw, int NGW, int lane) {
    for (int t = gw; t < T; t += NGW) {
        const int s0 = toks[2 * t], s1 = toks[2 * t + 1]; const float w0 = tokw[2 * t], w1 = tokw[2 * t + 1];
        f32x4* yr = (f32x4*)(y + (size_t)t * DM); const u32x2* a = (const u32x2*)(YS + (size_t)s0 * DM); const u32x2* b = (const u32x2*)(YS + (size_t)s1 * DM);
#pragma unroll
        for (int j = 0; j < 8; ++j) { f32x4 v = yr[lane + 64 * j]; const u32x2 x = a[lane + 64 * j], z = b[lane + 64 * j];
            v[0] += w0 * bf_lo(x.x) + w1 * bf_lo(z.x); v[1] += w0 * bf_hi(x.x) + w1 * bf_hi(z.x); v[2] += w0 * bf_lo(x.y) + w1 * bf_lo(z.y); v[3] += w0 * bf_hi(x.y) + w1 * bf_hi(z.y);
            yr[lane + 64 * j] = v; }
    }
}

constexpr int NPH_L = 13;
constexpr int NPHASES = 1 + NLAYER * NPH_L;
#ifndef PHMASK
#define PHMASK 0xFFFFFFFu
#endif
#define PHON(p) ((PHMASK >> (p)) & 1u)
#ifndef DUPMASK
#define DUPMASK 0u
#endif
#define NREP(p) (1 + (int)((DUPMASK >> (p)) & 1u))
#ifndef P3MASK
#define P3MASK 0x3Fu
#endif
#define P3ON(i) ((P3MASK >> (i)) & 1u)
#define WSP(T_, OFF) ((T_*)(ws + (OFF)))
#define IN(k) (lo <= (k) && (k) < hi)
constexpr int BG_LAST_SEAM = 1 + NPH_L + 8;
#define SEAM(k) do { if ((k) + 1 < hi) { XcdBarrier b2; b2.bar = (unsigned*)ld_tbl(lds, 31) + CW_BAR; b2.x = xb_xcc_id(); b2.st = (volatile LAS unsigned*)(lds + MISC_OFF) + 8; \
    if (!MK_PER_PHASE && (k) < BG_LAST_SEAM) xcd_barrier<true>(b2, lds); else xcd_barrier<false>(b2, lds); } } while (0)
#define PH_PRE() const int tid = launder_i(threadIdx.x), lane = tid & 63, wave = __builtin_amdgcn_readfirstlane(tid >> 6); \
                 const int vcu = (G % 8 == 0) ? (bid % 8) * (G / 8) + bid / 8 : bid; const int gw = vcu * 8 + wave, NGW = G * 8; \
                 unsigned char* ws = (unsigned char*)ld_tbl(lds, 31); (void)tid; (void)lane; (void)gw; (void)NGW; (void)ws
typedef pg8::Sched Sched;
template <int l> __device__ __forceinline__ void run_layer(LAS unsigned char* lds, const int lo, const int hi, const int G, const int bid) {
        const int P = 1 + l * NPH_L;
        if (l > 0 && PHON(0) && IN(P + 0)) { PH_PRE(); const float* ybase = (l == 0) ? INF(0) : INF(30);
            p_norm(ybase, INF(3) + l * DM, WSP(bf16, WS_H), WSP(unsigned char, WS_H8), INF(1), INF(15) + l * DM, WSP(bf16, WS_MEMN), gw, NGW, lane); SEAM(P + 0); }
        if (PHON(1) && IN(P + 1)) {
#pragma unroll 1
          for (int rep = 0; rep < NREP(1); ++rep) {
            { PH_PRE(); const bf16* W = WSP(const bf16, WS_W_IN) + (size_t)l * ZNB * DM;
              Sched S = pg8::make_sched(WSP(const bf16, WS_H), DM, W, DM, T / 256, ZNB / 256, G, bid);
              pg8::EpiBf16<0> E{WSP(bf16, WS_Z), ZW, 0, 0, nullptr, 1.f};
              pg8::gemm_phase<pg8::EpiBf16<0>, true>(lds, DM, DM, DM, S, E); }
            { PH_PRE(); const bf16* W8 = (const bf16*)(ws + WS_W_IN8 + (size_t)l * ZN8 * 2048);
              Sched S = pg8::make_sched(WSP(const bf16, WS_H8), DM / 2, W8, DM / 2, T / 256, ZN8 / 256, G, bid);
              pg8::EpiBf16<1> E{WSP(bf16, WS_Z) + ZC_CQ, ZW, (ZC_GATE - ZC_CQ) / 256, 1 << 30, nullptr, 1.0f / GATE_WSC};
              pg8::gemm_phase<pg8::EpiBf16<1>, true, true>(lds, DM / 2, DM / 2, DM / 2, S, E); }
          }
            SEAM(P + 1);
        }
        if (PHON(2) && IN(P + 2)) { PH_PRE(); p_postz(WSP(const bf16, WS_Z), WSP(float, WS_MOE + MO_RS), WSP(float, WS_MOE + MO_RQ), WSP(bf16, WS_POOLED), gw, NGW, lane); SEAM(P + 2); }
        if (PHON(3) && IN(P + 3)) {
#pragma unroll 1
          for (int rep = 0; rep < NREP(3); ++rep) {
            if (P3ON(0)) { PH_PRE(); const bf16* W = WSP(const bf16, WS_W_UQ) + (size_t)l * 1536 * 512;
              Sched S = pg8::make_sched(WSP(const bf16, WS_Z) + ZC_CQ, ZW, W, 512, T / 256, 6, (G * 3) / 4, bid < (G * 3) / 4 ? bid : (1 << 29));
              pg8::EpiBf16<0> E{WSP(bf16, WS_QB), 1536, 0, 0, nullptr, 1.f}; pg8::gemm_phase<pg8::EpiBf16<0>, true>(lds, 512, ZW, 512, S, E); }
            if (P3ON(1)) { PH_PRE(); const bf16* W = WSP(const bf16, WS_W_UKV) + (size_t)l * 2048 * 256;
              Sched S = pg8::make_sched(WSP(const bf16, WS_Z) + ZC_CKV, ZW, W, 256, T / 256, 4, G, (bid + 128) % G);
              pg8::EpiBf16<4> E{WSP(bf16, WS_KNOPE), 1024, 0, 0, WSP(const float, WS_MOE + MO_RS), 1.f}; pg8::gemm_phase<pg8::EpiBf16<4>, true>(lds, 256, ZW, 256, S, E); }
            if (P3ON(2)) { PH_PRE(); const bf16* W = WSP(const bf16, WS_W_UKV) + (size_t)l * 2048 * 256 + (size_t)1024 * 256;
              Sched S = pg8::make_sched(W, 256, WSP(const bf16, WS_Z) + ZC_CKV, ZW, 4, T / 256, G, bid);
              pg8::EpiBf16<2> E{WSP(bf16, WS_VT), T, 0, 0, WSP(const float, WS_MOE + MO_RS), 1.f}; pg8::gemm_phase<pg8::EpiBf16<2>, true>(lds, 256, 256, ZW, S, E); }
            if (P3ON(3)) { PH_PRE(); const bf16* W = WSP(const bf16, WS_W_POOL) + (size_t)l * 1024 * 256;
              Sched S = pg8::make_sched(WSP(const bf16, WS_POOLED), 1024, W, 256, T / 256, 4, G, bid); S.a_pn = 256 * 2;
              pg8::EpiBf16<2> E{WSP(bf16, WS_MIXED), 1024, 0, 0, INF(13) + l * 1024, 1.f}; pg8::gemm_phase<pg8::EpiBf16<2>, true>(lds, 256, 1024, 256, S, E); }
            if (P3ON(4)) { PH_PRE(); const bf16* W = WSP(const bf16, WS_W_MEMKV) + (size_t)l * 2048 * 2048;
              Sched S = pg8::make_sched(WSP(const bf16, WS_MEMN), DM, W, DM, MROWS / 256, 4, G, (bid + G / 4) % G);
              pg8::EpiBf16<0> E{WSP(bf16, WS_KM), 1024, 0, 0, nullptr, 1.f}; pg8::gemm_phase<pg8::EpiBf16<0>, true>(lds, DM, DM, DM, S, E); }
            if (P3ON(5)) { PH_PRE(); const bf16* W = WSP(const bf16, WS_W_MEMKV) + (size_t)l * 2048 * 2048 + (size_t)1024 * 2048;
              Sched S = pg8::make_sched(W, DM, WSP(const bf16, WS_MEMN), DM, 4, MROWS / 256, G, (bid + G / 8) % G);
              pg8::EpiBf16<0> E{WSP(bf16, WS_VMT), MROWS, 0, 0, nullptr, 1.f}; pg8::gemm_phase<pg8::EpiBf16<0>, true>(lds, DM, DM, DM, S, E); }
          }
            SEAM(P + 3);
        }
        if (PHON(4) && IN(P + 4)) { PH_PRE(); const float* ct = WSP(const float, WS_ROPE);
            p_postqkv(WSP(bf16, WS_QB), WSP(const bf16, WS_KNOPE), WSP(const bf16, WS_Z), WSP(bf16, WS_KB), WSP(bf16, WS_KM), INF(9) + l * 192, INF(10) + l * 192, INF(18) + l * 256, INF(17) + l * 256,
                      ct, ct + (size_t)T * 32, gw, NGW, lane); SEAM(P + 4); }
        if (PHON(5) && IN(P + 5)) { PH_PRE(); p_attention(lds, ws, G, bid);
#ifdef DUP_ATT
            __syncthreads(); p_attention(lds, ws, G, bid);
#endif
            SEAM(P + 5); }
        if (PHON(6) && IN(P + 6)) { PH_PRE();
            pg8::SchedChain3 S; S.so.init(T / 256, 8, G, bid); S.a_tile = (size_t)256 * 1024 * 2; S.b_tile = (size_t)256 * 1024 * 2; S.a_sub = 32 * MiB; S.b_sub = 8 * MiB;
            S.A = (const char*)WSP(const bf16, WS_MIXED); S.B = (const char*)(WSP(const bf16, WS_W_POOLOUT) + (size_t)l * 2048 * 1024);
            static_assert(WS_OMLA == WS_MIXED + 32 * MiB && WS_OMEM == WS_MIXED + 64 * MiB && WS_W_MLAOUT == WS_W_POOLOUT + 8 * MiB && WS_W_MEMOUT == WS_W_POOLOUT + 16 * MiB, "chain strides");
            pg8::EpiChain3 E{WSP(const bf16, WS_Z) + ZC_GATE, ZW, 2048, WSP(bf16, WS_MERGED), DM};
#pragma unroll 1
            for (int rep = 0; rep < NREP(6); ++rep) pg8::gemm_phase<pg8::EpiChain3, true, false, pg8::SchedChain3>(lds, 1024, 1024, 1024, S, E);
            SEAM(P + 6);
        }
        if (PHON(7) && IN(P + 7)) { PH_PRE(); const float* ybase = (l == 0) ? INF(0) : INF(30);
            const bf16* W = WSP(const bf16, WS_W_O) + (size_t)l * 2048 * 2048; Sched S = pg8::make_sched(WSP(const bf16, WS_MERGED), DM, W, DM, T / 256, 8, G, bid);
            pg8::EpiResid E{ybase, (float*)INF(30), DM}; pg8::gemm_phase<pg8::EpiResid, true>(lds, DM, DM, DM, S, E);
            SEAM(P + 7);
        }
        if (PHON(8) && IN(P + 8)) { PH_PRE();
            if (l == 0) p_norm(INF(30), INF(21) + l * DM, WSP(bf16, WS_H), nullptr, nullptr, nullptr, nullptr, gw, NGW, lane);
            else { moe_bg_drain(lds, wave, lane); __syncthreads();
                p_ffnnorm_router(lds, INF(30), INF(21) + l * DM, WSP(bf16, WS_H), INF(25), INF(26), WSP(int, WS_MOE + MO_TOKE), WSP(float, WS_MOE + MO_TOKW), WSP(int, WS_MOE + MO_HIST), G, bid, tid, wave, lane); }
            SEAM(P + 8);
        }
        if (l == 0) {
            if (PHON(9) && IN(P + 9)) { PH_PRE(); Sched S = pg8::make_sched(WSP(const bf16, WS_H), DM, WSP(const bf16, WS_W_DGU), DM, T / 256, 2 * DFF / 256, G, bid);
                pg8::EpiSwiGLU E{WSP(bf16, WS_G), DFF};
#pragma unroll 1
                for (int rep = 0; rep < NREP(9); ++rep) pg8::gemm_phase<pg8::EpiSwiGLU, true>(lds, DM, DM, DM, S, E); SEAM(P + 9); }
            if (PHON(10) && IN(P + 10)) { PH_PRE(); Sched S = pg8::make_sched(WSP(const bf16, WS_G), DFF, WSP(const bf16, WS_W_DD), DFF, T / 256, 8, G, bid);
                pg8::EpiResid E{INF(30), (float*)INF(30), DM}; pg8::gemm_phase<pg8::EpiResid, true>(lds, DFF, DFF, DFF, S, E); SEAM(P + 10); }
        } else {
            if (PHON(9) && IN(P + 9)) { PH_PRE(); p_moe_assign(lds, WSP(const bf16, WS_H), WSP(const int, WS_MOE + MO_TOKE), WSP(const int, WS_MOE + MO_HIST), WSP(int, WS_MOE + MO_TOKS), WSP(int, WS_MOE + MO_TILEE), WSP(unsigned char, WS_XG), G, bid, tid, wave, lane); SEAM(P + 9); }
            if (PHON(10) && IN(P + 10)) { PH_PRE(); const int* tilee_g = WSP(const int, WS_MOE + MO_TILEE); const int ntl = __builtin_amdgcn_readfirstlane(ld_agent_i(tilee_g + MAXTILES));
                LAS int* tilee = (LAS int*)(lds + TILEE_OFF); if (tid < MAXTILES) tilee[tid] = ld_agent_i(tilee_g + tid); __syncthreads();
                Sched S = pg8::make_sched(WSP(const bf16, WS_XG), DM / 2, WSP(const bf16, WS_W_MGU), DM / 2, ntl, 2 * DFE / 256, G, bid); S.tile_e = tilee; S.b_exp = (size_t)14336 * 2048;
                pg8::EpiSwiGLU8 E{WSP(unsigned char, WS_GM), DFE, 1.0f / MOE_WSC_UP, MOE_GSC};
#pragma unroll 1
                for (int rep = 0; rep < NREP(10); ++rep) pg8::gemm_phase<pg8::EpiSwiGLU8, true, true>(lds, DM / 2, DM / 2, DM / 2, S, E); SEAM(P + 10); }
            if (PHON(11) && IN(P + 11)) { PH_PRE(); const int* tilee_g = WSP(const int, WS_MOE + MO_TILEE); const int ntl = __builtin_amdgcn_readfirstlane(ld_agent_i(tilee_g + MAXTILES));
                LAS int* tilee = (LAS int*)(lds + TILEE_OFF); if (tid < MAXTILES) tilee[tid] = ld_agent_i(tilee_g + tid); __syncthreads();
                Sched S = pg8::make_sched(WSP(const bf16, WS_GM), DFE / 2, WSP(const bf16, WS_W_MD), DFE / 2, ntl, 8, G, bid); S.tile_e = tilee; S.b_exp = (size_t)2048 * DFE;
                pg8::EpiBf16<3> E{WSP(bf16, WS_YS), DM, 0, 0, nullptr, 1.0f / (MOE_GSC * MOE_WSC_DN)};
#pragma unroll 1
                for (int rep = 0; rep < NREP(11); ++rep) pg8::gemm_phase<pg8::EpiBf16<3>, true, true>(lds, DFE / 2, DFE / 2, DFE / 2, S, E); SEAM(P + 11); }
            if (PHON(12) && IN(P + 12)) { PH_PRE(); p_moe_combine((float*)INF(30), WSP(const bf16, WS_YS), WSP(const int, WS_MOE + MO_TOKS), WSP(const float, WS_MOE + MO_TOKW), gw, NGW, lane); }
        }
}
__global__ void __launch_bounds__(512, 2) mega_fwd(Args args) {
    extern __shared__ __attribute__((aligned(16))) unsigned char lds_raw[];
    LAS unsigned char* lds = (LAS unsigned char*)lds_raw;
    volatile LAS unsigned* MISC = (volatile LAS unsigned*)(lds + MISC_OFF);
    const int tid0 = threadIdx.x;
    for (int u = tid0; u < (LDS_BYTES - LDSCTL_OFF) / 4; u += 512) ((LAS unsigned*)(lds + LDSCTL_OFF))[u] = 0u;
    __syncthreads();
    if (tid0 == 0) { LAS unsigned long long* tb = (LAS unsigned long long*)(lds + TBL_OFF);
#pragma unroll
        for (int i = 0; i < 30; ++i) tb[i] = (unsigned long long)args.in[i];
        tb[30] = (unsigned long long)args.out; tb[31] = (unsigned long long)args.ws; }
    const int lo = args.ph_lo, hi = args.ph_hi;
    __syncthreads();
    const int G = gridDim.x, bid = blockIdx.x;
    if (!MK_PER_PHASE) (void)xcd_barrier_post((unsigned*)ld_tbl(lds, 31) + CW_BAR, MISC + 8);
    if (PHON(20) && IN(0)) { PH_PRE(); p_prologue(lds, gw, NGW, wave, lane);
#ifdef DUP_PRO
        __syncthreads(); p_prologue(lds, gw, NGW, wave, lane);
#endif
        p_norm(INF(0), INF(3), WSP(bf16, WS_H), WSP(unsigned char, WS_H8), INF(1), INF(15), WSP(bf16, WS_MEMN), gw, NGW, lane);
        SEAM(0); }
    run_layer<0>(lds, lo, hi, G, bid);
    run_layer<1>(lds, lo, hi, G, bid);
}
#undef IN
#undef SEAM


extern "C" void kernel_launch(void* const* d_in, const int* in_sizes, int n_in, void* d_out, int out_size, void* d_ws, size_t ws_size, hipStream_t stream) {
    static int grid = 0;
    if (grid == 0) {
        if (n_in != 30 || out_size != T * DM || ws_size < WS_END) { fprintf(stderr, "kernel_launch: unexpected shapes (n_in %d out %d ws %zu, need ws >= %zu)\n", n_in, out_size, ws_size, (size_t)WS_END); grid = -1; return; }
        int dev = 0, cus = 0, per_cu = 0;
        if (hipGetDevice(&dev) != hipSuccess || hipDeviceGetAttribute(&cus, hipDeviceAttributeMultiprocessorCount, dev) != hipSuccess) { grid = -1; return; }
        if (hipFuncSetAttribute((const void*)mega_fwd, hipFuncAttributeMaxDynamicSharedMemorySize, LDS_BYTES) != hipSuccess) { fprintf(stderr, "kernel_launch: hipFuncSetAttribute failed\n"); grid = -1; return; }
        if (hipOccupancyMaxActiveBlocksPerMultiprocessor(&per_cu, (const void*)mega_fwd, 512, LDS_BYTES) != hipSuccess || per_cu < 1) fprintf(stderr, "kernel_launch: occupancy query says %d\n", per_cu);
        (void)hipGetLastError();
        grid = cus;
    }
    if (grid < 0) return;
    (void)hipMemsetAsync((char*)d_ws + WS_CTL, 0, CTL_ZERO_BYTES, stream);
    Args a{};
    for (int i = 0; i < 30; ++i) a.in[i] = d_in[i];
    a.out = (float*)d_out; a.ws = (unsigned char*)d_ws;
#if MK_PER_PHASE
    for (int k = 0; k < NPHASES; ++k) { a.ph_lo = k; a.ph_hi = k + 1; hipLaunchKernelGGL(mega_fwd, dim3(grid), dim3(512), LDS_BYTES, stream, a); }
#else
    a.ph_lo = 0; a.ph_hi = NPHASES;
    hipLaunchKernelGGL(mega_fwd, dim3(grid), dim3(512), LDS_BYTES, stream, a);
#endif
}
```
